# Optimizing an MI355X kernel written in HIP

```python
import jax, jax.numpy as jnp
from jax import lax
import numpy as np

D_MODEL = 1024
BATCH = 8
SEQ = 2048
DEPTH = 1

N_MEM = 256
D_MIX = D_MODEL
D_SGU = D_MIX // 2
D_ATT = D_MIX - D_SGU
SGU_GROUPS = 8
SGU_GROUP_DIM = D_SGU // SGU_GROUPS
CHUNK = 128
N_HEADS = 8
HEAD_DIM = D_ATT // N_HEADS
DILATED_CONFIGS = ((128, 1), (512, 4), (2048, 16))
ROPE_THETA = 500000.0
ROPE_DIM = HEAD_DIM // 4
X_HEADS = 4
X_HEAD_DIM = D_MODEL // X_HEADS
D_FF = 2816
D_IN = 2 * D_SGU + 3 * D_ATT
NORM_EPS = 1e-6
LN_EPS = 1e-5
MAX_POS_OFFSET = 4096

kernel_name = "hybrid_sgu_dilated_attn_macaron_layer"

F32 = jnp.float32


def rmsnorm(t, g):
    tf = t.astype(F32)
    y = tf * lax.rsqrt(jnp.mean(tf * tf, axis=-1, keepdims=True) + NORM_EPS)
    return (y * g.astype(F32)).astype(t.dtype)


def group_layernorm(t, g, b):
    G, C = t.shape[-2], t.shape[-1]
    tf = t.astype(F32)
    mu = jnp.mean(tf, axis=-1, keepdims=True)
    d = tf - mu
    y = d * lax.rsqrt(jnp.mean(d * d, axis=-1, keepdims=True) + LN_EPS)
    return (y * g.astype(F32).reshape(G, C) + b.astype(F32).reshape(G, C)).astype(t.dtype)


def swiglu(h, w_gate, w_up, w_down):
    return (jax.nn.silu(h @ w_gate) * (h @ w_up)) @ w_down


def partial_rotary(t, positions):
    half = ROPE_DIM // 2
    inv_freq = ROPE_THETA ** (-2.0 * jnp.arange(half, dtype=F32) / ROPE_DIM)
    ang = positions.astype(F32)[..., None] * inv_freq
    cos = jnp.cos(ang)[:, :, None, :]
    sin = jnp.sin(ang)[:, :, None, :]
    tf = t.astype(F32)
    x1 = tf[..., :half]
    x2 = tf[..., half:ROPE_DIM]
    out = jnp.concatenate([x1 * cos - x2 * sin, x2 * cos + x1 * sin, tf[..., ROPE_DIM:]], axis=-1)
    return out.astype(t.dtype)


def chunked_spatial_gating(z, ln_g, ln_b, w_s, b_s):
    b, s, _ = z.shape
    u, v = z[..., :D_SGU], z[..., D_SGU:]
    v = group_layernorm(v.reshape(b, s, SGU_GROUPS, SGU_GROUP_DIM), ln_g, ln_b)
    v = v.reshape(b, s // CHUNK, CHUNK, SGU_GROUPS, SGU_GROUP_DIM)
    causal = jnp.tril(jnp.ones((CHUNK, CHUNK), dtype=bool))
    ws = w_s * causal.astype(w_s.dtype)
    mixed = jnp.einsum('gij,bnjgc->bnigc', ws, v) + b_s.T[:, :, None]
    return u * mixed.reshape(b, s, D_SGU)


def dilated_window_attention(q, k, v, window, dilation):
    b, s, h, e = q.shape
    band = window // dilation
    L = s // dilation
    nb = -(-L // band)
    Lp = nb * band
    qs = q.reshape(b, L, dilation, h, e)
    ks = k.reshape(b, L, dilation, h, e)
    vs = v.reshape(b, L, dilation, h, e)
    qb = jnp.pad(qs, ((0, 0), (0, Lp - L), (0, 0), (0, 0), (0, 0))).reshape(b, nb, band, dilation, h, e)

    def kv_blocks(t):
        t = jnp.pad(t, ((0, 0), (band, Lp - L), (0, 0), (0, 0), (0, 0))).reshape(b, nb + 1, band, dilation, h, e)
        return jnp.concatenate([t[:, :-1], t[:, 1:]], axis=2)

    kb, vb = kv_blocks(ks), kv_blocks(vs)
    scores = jnp.einsum('bnqrhe,bnkrhe->bnrhqk', qb.astype(F32), kb.astype(F32)) * (e ** -0.5)
    qi = jnp.arange(band)[:, None]
    kj = jnp.arange(2 * band)[None, :]
    dist = band + qi - kj
    key_pos = (jnp.arange(nb)[:, None, None] - 1) * band + kj[None]
    mask = ((dist >= 0) & (dist <= band))[None] & (key_pos >= 0)
    scores = jnp.where(mask[None, :, None, None], scores, -jnp.inf)
    lse = jax.nn.logsumexp(scores, axis=-1)
    p = jnp.exp(scores - lse[..., None])
    o = jnp.einsum('bnrhqk,bnkrhe->bnqrhe', p.astype(v.dtype), vb)
    o = o.reshape(b, Lp, dilation, h, e)[:, :L].reshape(b, s, h, e)
    lse = jnp.transpose(lse, (0, 1, 4, 2, 3)).reshape(b, Lp, dilation, h)[:, :L].reshape(b, s, h)
    return o, lse


def dilated_mixture_attention(q, k, v):
    outs, lses = [], []
    for window, dilation in DILATED_CONFIGS:
        o, l = dilated_window_attention(q, k, v, window, dilation)
        outs.append(o)
        lses.append(l)
    wts = jax.nn.softmax(jnp.stack(lses, axis=0), axis=0)
    return jnp.einsum('gbsh,gbshe->bshe', wts.astype(q.dtype), jnp.stack(outs, axis=0))


def memory_cross_attention(h, m, wq, wk, wv, wo):
    b, s, _ = h.shape
    nm = m.shape[1]
    q = (h @ wq).reshape(b, s, X_HEADS, X_HEAD_DIM)
    k = (m @ wk).reshape(b, nm, X_HEADS, X_HEAD_DIM)
    v = (m @ wv).reshape(b, nm, X_HEADS, X_HEAD_DIM)
    scores = jnp.einsum('bshe,bmhe->bhsm', q.astype(F32), k.astype(F32)) * (X_HEAD_DIM ** -0.5)
    p = jax.nn.softmax(scores, axis=-1)
    o = jnp.einsum('bhsm,bmhe->bshe', p.astype(v.dtype), v)
    return o.reshape(b, s, D_MODEL) @ wo


def setup_inputs(seed: int = 0) -> dict:
    key = jax.random.key(seed)
    ks = jax.random.split(key, 32)

    def w(k, shape, fan_in):
        return jax.random.normal(k, shape, F32) * (fan_in ** -0.5)

    def gain(k, shape):
        return 1.0 + 0.02 * jax.random.normal(k, shape, F32)

    L = DEPTH
    x = jax.random.normal(ks[0], (BATCH, SEQ, D_MODEL), F32)
    mem = jax.random.normal(ks[1], (BATCH, N_MEM, D_MODEL), F32)
    start = jax.random.randint(ks[2], (BATCH, 1), 0, MAX_POS_OFFSET, dtype=jnp.int32)
    positions = (start + jnp.arange(SEQ, dtype=jnp.int32)[None, :]).astype(jnp.int32)
    return {
        "x": x,
        "mem": mem,
        "positions": positions,
        "ffn1_norm": gain(ks[3], (L, D_MODEL)),
        "ffn1_w_gate": w(ks[4], (L, D_MODEL, D_FF), D_MODEL),
        "ffn1_w_up": w(ks[5], (L, D_MODEL, D_FF), D_MODEL),
        "ffn1_w_down": w(ks[6], (L, D_FF, D_MODEL), D_FF),
        "mix_norm": gain(ks[7], (L, D_MODEL)),
        "w_in": w(ks[8], (L, D_MODEL, D_IN), D_MODEL),
        "sgu_ln_g": gain(ks[9], (L, D_SGU)),
        "sgu_ln_b": 0.02 * jax.random.normal(ks[10], (L, D_SGU), F32),
        "sgu_w_s": w(ks[11], (L, SGU_GROUPS, CHUNK, CHUNK), CHUNK),
        "sgu_b_s": 1.0 + 0.1 * jax.random.normal(ks[12], (L, SGU_GROUPS, CHUNK), F32),
        "out_norm_a": gain(ks[13], (L, D_SGU)),
        "out_norm_b": gain(ks[14], (L, D_ATT)),
        "w_out": w(ks[15], (L, D_MIX, D_MODEL), D_MIX),
        "cross_norm": gain(ks[16], (L, D_MODEL)),
        "mem_norm": gain(ks[17], (L, D_MODEL)),
        "cross_wq": w(ks[18], (L, D_MODEL, D_MODEL), D_MODEL),
        "cross_wk": w(ks[19], (L, D_MODEL, D_MODEL), D_MODEL),
        "cross_wv": w(ks[20], (L, D_MODEL, D_MODEL), D_MODEL),
        "cross_wo": w(ks[21], (L, D_MODEL, D_MODEL), D_MODEL),
        "ffn2_norm": gain(ks[22], (L, D_MODEL)),
        "ffn2_w_gate": w(ks[23], (L, D_MODEL, D_FF), D_MODEL),
        "ffn2_w_up": w(ks[24], (L, D_MODEL, D_FF), D_MODEL),
        "ffn2_w_down": w(ks[25], (L, D_FF, D_MODEL), D_FF),
        "final_norm": gain(ks[26], (D_MODEL,)),
    }


def reference(x, mem, positions, ffn1_norm, ffn1_w_gate, ffn1_w_up, ffn1_w_down,
              mix_norm, w_in, sgu_ln_g, sgu_ln_b, sgu_w_s, sgu_b_s,
              out_norm_a, out_norm_b, w_out, cross_norm, mem_norm,
              cross_wq, cross_wk, cross_wv, cross_wo,
              ffn2_norm, ffn2_w_gate, ffn2_w_up, ffn2_w_down, final_norm):
    b, s, _ = x.shape
    for l in range(DEPTH):
        h = rmsnorm(x, ffn1_norm[l])
        x = x + 0.5 * swiglu(h, ffn1_w_gate[l], ffn1_w_up[l], ffn1_w_down[l])

        h = rmsnorm(x, mix_norm[l])
        z = h @ w_in[l]
        z_sgu = jax.nn.gelu(z[..., :2 * D_SGU], approximate=False)
        o0 = 2 * D_SGU
        q = z[..., o0:o0 + D_ATT].reshape(b, s, N_HEADS, HEAD_DIM)
        k = z[..., o0 + D_ATT:o0 + 2 * D_ATT].reshape(b, s, N_HEADS, HEAD_DIM)
        v = z[..., o0 + 2 * D_ATT:o0 + 3 * D_ATT].reshape(b, s, N_HEADS, HEAD_DIM)
        q = partial_rotary(q, positions)
        k = partial_rotary(k, positions)

        y_a = chunked_spatial_gating(z_sgu, sgu_ln_g[l], sgu_ln_b[l], sgu_w_s[l], sgu_b_s[l])
        y_b = dilated_mixture_attention(q, k, v).reshape(b, s, D_ATT)
        y = jnp.concatenate([rmsnorm(y_a, out_norm_a[l]), rmsnorm(y_b, out_norm_b[l])], axis=-1)
        x = x + y @ w_out[l]

        h = rmsnorm(x, cross_norm[l])
        m = rmsnorm(mem, mem_norm[l])
        x = x + memory_cross_attention(h, m, cross_wq[l], cross_wk[l], cross_wv[l], cross_wo[l])

        h = rmsnorm(x, ffn2_norm[l])
        x = x + 0.5 * swiglu(h, ffn2_w_gate[l], ffn2_w_up[l], ffn2_w_down[l])
    return rmsnorm(x, final_norm)
```

```cpp
#include <hip/hip_runtime.h>
#include <cstdio>
#include <cstdint>

#ifndef MK_PER_PHASE
#define MK_PER_PHASE 0
#endif
#ifndef MK_DEBUG
#define MK_DEBUG 0
#endif

#define LAS __attribute__((address_space(3)))
#define GAS __attribute__((address_space(1)))
typedef unsigned short bf16;
typedef short bf16x8 __attribute__((ext_vector_type(8)));
typedef float f32x4 __attribute__((ext_vector_type(4)));
typedef float f32x2 __attribute__((ext_vector_type(2)));
typedef float f32x16 __attribute__((ext_vector_type(16)));
typedef unsigned u32x4 __attribute__((ext_vector_type(4)));
typedef unsigned u32x2 __attribute__((ext_vector_type(2)));
typedef __bf16 bf16x2_t __attribute__((ext_vector_type(2)));
typedef short v4i16_t __attribute__((ext_vector_type(4)));

constexpr int BATCH = 8, SEQ = 2048, T = BATCH * SEQ, DM = 1024, FF = 2816, NMEM = 256, MT = BATCH * NMEM;
constexpr int NPH = 13;
constexpr float QSCALE = 0.125f * 1.4426950408889634f;
constexpr float XSCALE = 0.0625f * 1.4426950408889634f;
constexpr float NORM_EPS = 1e-6f, LN_EPS = 1e-5f;

constexpr size_t MiB = 1u << 20;
constexpr size_t WS_CTL = 0, CTL_ZERO_BYTES = 1 * MiB;
constexpr size_t WS_WGU1 = 1 * MiB, WS_WD1 = 12 * MiB, WS_WIN = 18 * MiB, WS_WOUT = 23 * MiB, WS_WQ = 25 * MiB, WS_WK = 27 * MiB, WS_WV = 29 * MiB,
                 WS_WO = 31 * MiB, WS_WGU2 = 33 * MiB, WS_WD2 = 44 * MiB;
constexpr size_t WS_WSB = 50 * MiB;
constexpr size_t WS_ROPE = 50 * MiB + 512 * 1024;
constexpr size_t WS_SS = 52 * MiB;
constexpr size_t WS_RSM = 53 * MiB;
constexpr size_t WS_SSA = 53 * MiB + 512 * 1024;
constexpr size_t WS_LSE = 54 * MiB;
constexpr size_t WS_MEMB = 56 * MiB, WS_KC = 60 * MiB, WS_VT = 64 * MiB;
constexpr size_t WS_XB = 68 * MiB;
constexpr size_t WS_R = 100 * MiB;
constexpr size_t WS_ACT = WS_R;
constexpr size_t WS_U = WS_R, WS_VTS = WS_R + 16 * MiB, WS_QB = WS_R + 32 * MiB, WS_KB = WS_R + 48 * MiB, WS_VB = WS_R + 64 * MiB,
                 WS_YA = WS_R + 80 * MiB, WS_OG = WS_R + 96 * MiB;
constexpr size_t WS_Y = WS_R;
constexpr size_t WS_QX = WS_R + 32 * MiB, WS_OX = WS_R + 64 * MiB;
constexpr size_t WS_END = 256 * MiB;
static_assert(WS_OG + 48 * MiB <= WS_END && WS_KB == WS_QB + 16 * MiB && WS_VB == WS_KB + 16 * MiB, "ws map");

constexpr int CW_BAR = 4096;
constexpr int CW_DBG = 65536;

constexpr int RING_BYTES = 131072;
constexpr int LDSCTL_OFF = 139264, MISC_OFF = LDSCTL_OFF + 320;
constexpr int LDS_BYTES = 147456;

__device__ __forceinline__ unsigned pk2(float lo, float hi) { f32x2 v = {lo, hi}; bf16x2_t b = __builtin_convertvector(v, bf16x2_t); return __builtin_bit_cast(unsigned, b); }
__device__ __forceinline__ float bf2f(bf16 v) { return __uint_as_float((unsigned)v << 16); }
__device__ __forceinline__ float bflo(unsigned w) { return __uint_as_float(w << 16); }
__device__ __forceinline__ float bfhi(unsigned w) { return __uint_as_float(w & 0xffff0000u); }
__device__ __forceinline__ u32x4 pack8(f32x4 a, f32x4 b) { u32x4 w; w.x = pk2(a[0], a[1]); w.y = pk2(a[2], a[3]); w.z = pk2(b[0], b[1]); w.w = pk2(b[2], b[3]); return w; }
__device__ __forceinline__ float wave_sum(float v) {
#pragma unroll
    for (int o = 1; o < 64; o <<= 1) v += __shfl_xor(v, o);
    return v;
}
__device__ __forceinline__ float red16(float v) {
    v += __shfl_xor(v, 1); v += __shfl_xor(v, 2); v += __shfl_xor(v, 4); v += __shfl_xor(v, 8); return v;
}
__device__ __forceinline__ int crow(int r, int hi) { return (r & 3) + 8 * (r >> 2) + 4 * hi; }
__device__ __forceinline__ float rowrs(const float* ss, int row) {
    const f32x4* p = (const f32x4*)(ss + (size_t)row * 16);
    const f32x4 s = (p[0] + p[1]) + (p[2] + p[3]);
    return __builtin_amdgcn_rsqf(((s[0] + s[1]) + (s[2] + s[3])) * (1.0f / 1024.0f) + NORM_EPS);
}
__device__ __forceinline__ f32x2 gelu_pk(f32x2 v) {
    const f32x2 av = __builtin_elementwise_abs(v), d = av * 0.2316418882f + 1.0f;
    f32x2 t; t.x = __builtin_amdgcn_rcpf(d.x); t.y = __builtin_amdgcn_rcpf(d.y);
    f32x2 q = t * 0.5307027145f + (-0.7265760135f); q = q * t + 0.7107068705f; q = q * t + (-0.142248368f); q = q * t + 0.127414796f; q = q * t;
    const f32x2 s = (v * v) * (-0.72134752044f);
    f32x2 e; e.x = __builtin_amdgcn_exp2f(s.x); e.y = __builtin_amdgcn_exp2f(s.y);
    const f32x2 m = v * (q * e), r = v - m;
    f32x2 o; o.x = v.x < 0.f ? m.x : r.x; o.y = v.y < 0.f ? m.y : r.y; return o;
}
__device__ __forceinline__ f32x4 gelu4(f32x4 v) { f32x2 a = gelu_pk((f32x2){v[0], v[1]}), b = gelu_pk((f32x2){v[2], v[3]}); return (f32x4){a.x, a.y, b.x, b.y}; }
__device__ __forceinline__ float silu1(float g) { return g * __builtin_amdgcn_rcpf(1.0f + __builtin_amdgcn_exp2f(-1.4426950408889634f * g)); }

namespace pg8 {
constexpr int BM = 256, BK = 64, HALF = 128, HTB = HALF * BK * 2, STAGE_BYTES = 8 * HTB, NXCD = 8;
__host__ __device__ __forceinline__ int lds_byte(int r, int c) { const int st = (r >> 4) * 2 + (c >> 5), rr = r & 15, cc = c & 31, ob = rr * 64 + cc * 2; return st * 1024 + (ob ^ (((ob >> 9) & 1) << 5)); }
__host__ __device__ __forceinline__ void stage_rc(int b, int& R, int& C) { const int st = b / 1024, sb = b % 1024, swz = sb ^ (((sb >> 9) & 1) << 5); R = (st >> 1) * 16 + swz / 64; C = (st & 1) * 32 + (swz % 64) / 2; }
__host__ __device__ __forceinline__ int perm32(int rho) { const int n = rho >> 4, i = rho & 15; return 8 * (i >> 2) + 4 * n + (i & 3); }

struct Unit { const char* a; const char* b; int pm, pn, kind; };

template <class Epi, class Sched>
__device__ __forceinline__ void gemm_phase(LAS unsigned char* lds, const int K, const Sched& S, const Epi& E) {
    const int tid = threadIdx.x, wid = __builtin_amdgcn_readfirstlane(tid >> 6), lane = tid & 63, wr = wid >> 2, wc = wid & 3, fr = lane & 15, fq = lane >> 4;
    const int nt = K / BK;
    unsigned voffA[2], voffB[2];
#pragma unroll
    for (int i = 0; i < 2; ++i) { int R, C; stage_rc(tid * 16 + i * 8192, R, C); const int Rb = (R & ~31) + perm32(R & 31);
        voffA[i] = (unsigned)(R * K + C) * 2u; voffB[i] = (unsigned)(Rb * K + C) * 2u; }
    const size_t kstep = (size_t)(BK * 2);
    const size_t hstep = (size_t)HALF * K * 2;
    const unsigned ldsw = (unsigned)wid * 1024u;
    const int aoff = lds_byte(wr * 64 + fr, fq * 8), boff = lds_byte(wc * 32 + fr, fq * 8);
#define PG8_SA(b, h) (((b) * 2 + (h)) * HTB)
#define PG8_SB(b, h) ((4 + (b) * 2 + (h)) * HTB)
#define PG8_STAGE(bufoff, gbase, voff) do { _Pragma("unroll") for (int _i = 0; _i < 2; ++_i) \
        __builtin_amdgcn_global_load_lds((const unsigned*)((const char*)(gbase) + (voff)[_i]), (LAS unsigned*)(lds + (bufoff) + ldsw + _i * 8192), 16, 0, 0); } while (0)
#define PG8_LDA(dst, b, h) do { _Pragma("unroll") for (int m = 0; m < 4; ++m) _Pragma("unroll") for (int k = 0; k < 2; ++k) dst[m][k] = *(const LAS bf16x8*)(lds + PG8_SA(b, h) + aoff + m * 2048 + k * 1024); } while (0)
#define PG8_LDB(dst, b, h) do { _Pragma("unroll") for (int n = 0; n < 2; ++n) _Pragma("unroll") for (int k = 0; k < 2; ++k) dst[n][k] = *(const LAS bf16x8*)(lds + PG8_SB(b, h) + boff + n * 2048 + k * 1024); } while (0)
#define PG8_MMA(ai, bj, At, Bt) do { __builtin_amdgcn_s_setprio(1); _Pragma("unroll") for (int m = 0; m < 4; ++m) _Pragma("unroll") for (int n = 0; n < 2; ++n) _Pragma("unroll") for (int k = 0; k < 2; ++k) \
        acc[ai][bj][m][n] = __builtin_amdgcn_mfma_f32_16x16x32_bf16(Bt[n][k], At[m][k], acc[ai][bj][m][n], 0, 0, 0); __builtin_amdgcn_s_setprio(0); } while (0)
#define PG8_WAIT_V(n) asm volatile("s_waitcnt vmcnt(" #n ")" ::: "memory")
#define PG8_WAIT_L(n) asm volatile("s_waitcnt lgkmcnt(" #n ")" ::: "memory")
#define PG8_BAR __builtin_amdgcn_s_barrier()
#define PG8_SCHED __builtin_amdgcn_sched_barrier(0)
    Unit cur, nxt; int ui = 0;
    if (!S.next(0, cur)) return;
    f32x4 acc[2][2][4][2];
#pragma unroll
    for (int a = 0; a < 2; ++a)
#pragma unroll
        for (int b = 0; b < 2; ++b)
#pragma unroll
            for (int m = 0; m < 4; ++m)
#pragma unroll
                for (int n = 0; n < 2; ++n) acc[a][b][m][n] = (f32x4){0.f, 0.f, 0.f, 0.f};
    bf16x8 At[4][2], B0[2][2], B1[2][2];
    const char* cA = cur.a; const char* cB = cur.b;
    PG8_STAGE(PG8_SB(0, 0), cB, voffB); PG8_STAGE(PG8_SB(0, 1), cB + hstep, voffB); PG8_STAGE(PG8_SA(0, 0), cA, voffA); PG8_STAGE(PG8_SA(0, 1), cA + hstep, voffA);
    if (wr == 1) PG8_BAR;
    PG8_WAIT_V(2); PG8_BAR;
    PG8_STAGE(PG8_SB(1, 0), cB + kstep, voffB); PG8_STAGE(PG8_SA(1, 0), cA + kstep, voffA); PG8_STAGE(PG8_SB(1, 1), cB + hstep + kstep, voffB);
    PG8_WAIT_V(6); PG8_BAR;
    for (;;) {
        const bool has_next = S.next(ui + 1, nxt);
        const char* nA = has_next ? nxt.a : cA; const char* nB = has_next ? nxt.b : cB;
        for (int t = 0; t < nt; t += 2) {
            const bool last = (t == nt - 2);
            const char* a1 = cA + (size_t)(t + 1) * kstep;
            const char* a2 = last ? nA : cA + (size_t)(t + 2) * kstep; const char* b2 = last ? nB : cB + (size_t)(t + 2) * kstep;
            const char* a3 = a2 + kstep; const char* b3 = b2 + kstep;
            PG8_LDB(B0, 0, 0); PG8_LDB(B1, 0, 1); PG8_SCHED; PG8_LDA(At, 0, 0); PG8_STAGE(PG8_SA(1, 1), a1 + hstep, voffA);
            PG8_WAIT_V(8); PG8_WAIT_L(0); PG8_BAR; PG8_MMA(0, 0, At, B0); PG8_MMA(0, 1, At, B1); PG8_BAR; PG8_SCHED;
            PG8_LDA(At, 0, 1); PG8_STAGE(PG8_SB(0, 0), b2, voffB); PG8_STAGE(PG8_SB(0, 1), b2 + hstep, voffB); PG8_STAGE(PG8_SA(0, 0), a2, voffA);
            PG8_WAIT_V(8); PG8_WAIT_L(0); PG8_BAR; PG8_MMA(1, 0, At, B0); PG8_MMA(1, 1, At, B1); PG8_BAR; PG8_SCHED;
            PG8_LDB(B0, 1, 0); PG8_LDB(B1, 1, 1); PG8_SCHED; PG8_LDA(At, 1, 0); PG8_STAGE(PG8_SA(0, 1), a2 + hstep, voffA);
            PG8_WAIT_V(8); PG8_WAIT_L(0); PG8_BAR; PG8_MMA(0, 0, At, B0); PG8_MMA(0, 1, At, B1); PG8_BAR; PG8_SCHED;
            PG8_LDA(At, 1, 1); PG8_STAGE(PG8_SB(1, 0), b3, voffB); PG8_STAGE(PG8_SB(1, 1), b3 + hstep, voffB); PG8_STAGE(PG8_SA(1, 0), a3, voffA);
            PG8_WAIT_V(8); PG8_WAIT_L(0); PG8_BAR; PG8_MMA(1, 0, At, B0); PG8_MMA(1, 1, At, B1); PG8_BAR; PG8_SCHED;
        }
        if (wr == 0) PG8_BAR;
        { int fr2 = fr, fq2 = fq; asm volatile("" : "+v"(fr2), "+v"(fq2)); E(acc, cur, wr, wc, fr2, fq2); }
        if (!has_next) break;
#pragma unroll
        for (int a = 0; a < 2; ++a)
#pragma unroll
            for (int b = 0; b < 2; ++b)
#pragma unroll
                for (int m = 0; m < 4; ++m)
#pragma unroll
                    for (int n = 0; n < 2; ++n) acc[a][b][m][n] = (f32x4){0.f, 0.f, 0.f, 0.f};
        cur = nxt; cA = nA; cB = nB; ++ui;
        if (wr == 1) PG8_BAR;
    }
    PG8_WAIT_V(0);
    PG8_BAR;
#undef PG8_SA
#undef PG8_SB
#undef PG8_STAGE
#undef PG8_LDA
#undef PG8_LDB
#undef PG8_MMA
#undef PG8_WAIT_V
#undef PG8_WAIT_L
#undef PG8_BAR
#undef PG8_SCHED
}

template <class D> struct MultiSched {
    const char* base; int G, c;
    static constexpr int nwg = D::n0 + D::n1 + D::n2;
    template <int nM, int nN> __device__ __forceinline__ static void dec(int local, int& pm, int& pn) {
        constexpr int nig = 8 * nN; const int gid = local / nig, fm = gid * 8, gsz = (nM - fm) < 8 ? (nM - fm) : 8, rem = local % nig; pm = fm + rem % gsz; pn = rem / gsz; }
    __device__ __forceinline__ bool next(int i, Unit& u) const {
        const int L = i * G + c; if (L >= nwg) return false;
        int wgid; { constexpr int q = nwg / NXCD, r = nwg % NXCD; const int xcd = L % NXCD, off = L / NXCD; wgid = (xcd < r ? xcd * (q + 1) : r * (q + 1) + (xcd - r) * q) + off; }
        int pm, pn;
        if (wgid < D::n0) { dec<D::nM0, D::nN0>(wgid, pm, pn); u.kind = 0; u.a = base + D::A0 + (size_t)pm * D::tstep; u.b = base + D::B0 + (size_t)pn * D::tstep; }
        else if (wgid < D::n0 + D::n1) { dec<D::nM1, D::nN1>(wgid - D::n0, pm, pn); u.kind = 1; u.a = base + D::A1 + (size_t)pm * D::tstep; u.b = base + D::B1 + (size_t)pn * D::tstep; }
        else { dec<D::nM2, D::nN2>(wgid - D::n0 - D::n1, pm, pn); u.kind = 2; u.a = base + D::A2 + (size_t)pm * D::tstep; u.b = base + D::B2 + (size_t)pn * D::tstep; }
        u.pm = pm; u.pn = pn; return true;
    }
};
}
using pg8::Unit;
typedef f32x4 Acc[2][2][4][2];

struct EpiP1 {
    bf16* act; const float* ss; bf16* kc; bf16* vt; const float* rsm;
    __device__ __forceinline__ void operator()(const Acc& acc, const Unit& u, int wr, int wc, int fr, int fq) const {
        if (u.kind == 0) {
#pragma unroll
            for (int ai = 0; ai < 2; ++ai)
#pragma unroll
                for (int m = 0; m < 4; ++m) { const int row = u.pm * 256 + ai * 128 + wr * 64 + m * 16 + fr; const float rs = rowrs(ss, row);
                    f32x4 h0, h1;
#pragma unroll
                    for (int j = 0; j < 4; ++j) { h0[j] = silu1(acc[ai][0][m][0][j] * rs) * (acc[ai][1][m][0][j] * rs); h1[j] = silu1(acc[ai][0][m][1][j] * rs) * (acc[ai][1][m][1][j] * rs); }
                    *(u32x4*)(act + (size_t)row * FF + u.pn * 128 + wc * 32 + fq * 8) = pack8(h0, h1); }
        } else if (u.kind == 1) {
#pragma unroll
            for (int ai = 0; ai < 2; ++ai)
#pragma unroll
                for (int m = 0; m < 4; ++m) { const int row = u.pm * 256 + ai * 128 + wr * 64 + m * 16 + fr; const float rs = rsm[row];
#pragma unroll
                    for (int bj = 0; bj < 2; ++bj) *(u32x4*)(kc + (size_t)row * DM + u.pn * 256 + bj * 128 + wc * 32 + fq * 8) = pack8(acc[ai][bj][m][0] * rs, acc[ai][bj][m][1] * rs); }
        } else {
            f32x4 cs0[2], cs1[2];
#pragma unroll
            for (int bj = 0; bj < 2; ++bj) { const float* p = rsm + u.pn * 256 + bj * 128 + wc * 32 + fq * 8; cs0[bj] = *(const f32x4*)p; cs1[bj] = *(const f32x4*)(p + 4); }
#pragma unroll
            for (int ai = 0; ai < 2; ++ai)
#pragma unroll
                for (int m = 0; m < 4; ++m) { const int row = u.pm * 256 + ai * 128 + wr * 64 + m * 16 + fr;
#pragma unroll
                    for (int bj = 0; bj < 2; ++bj) *(u32x4*)(vt + (size_t)row * MT + u.pn * 256 + bj * 128 + wc * 32 + fq * 8) = pack8(acc[ai][bj][m][0] * cs0[bj], acc[ai][bj][m][1] * cs1[bj]); }
        }
    }
};
struct EpiRes {
    const float* resid; float* out; bf16* xb; float* ss; float alpha;
    __device__ __forceinline__ void operator()(const Acc& acc, const Unit& u, int wr, int wc, int fr, int fq) const {
#pragma unroll
        for (int ai = 0; ai < 2; ++ai)
#pragma unroll
            for (int m = 0; m < 4; ++m) { const int row = u.pm * 256 + ai * 128 + wr * 64 + m * 16 + fr; float sq = 0.f;
#pragma unroll
                for (int bj = 0; bj < 2; ++bj) { const size_t off = (size_t)row * DM + u.pn * 256 + bj * 128 + wc * 32 + fq * 8;
                    const f32x4 x0 = *(const f32x4*)(resid + off) + acc[ai][bj][m][0] * alpha, x1 = *(const f32x4*)(resid + off + 4) + acc[ai][bj][m][1] * alpha;
                    *(f32x4*)(out + off) = x0; *(f32x4*)(out + off + 4) = x1;
                    if (xb) *(u32x4*)(xb + off) = pack8(x0, x1);
                    sq += ((x0[0] * x0[0] + x0[1] * x0[1]) + (x0[2] * x0[2] + x0[3] * x0[3])) + ((x1[0] * x1[0] + x1[1] * x1[1]) + (x1[2] * x1[2] + x1[3] * x1[3])); }
                sq += __shfl_xor(sq, 16); sq += __shfl_xor(sq, 32);
                if (fq == 0) ss[(size_t)row * 16 + u.pn * 4 + wc] = sq; }
    }
};
struct EpiP3 {
    const float* ss; bf16* U; bf16* QB; const float* cs; bf16* VTS; const float* lng; const float* lnb;
    __device__ __forceinline__ void operator()(const Acc& acc, const Unit& u, int wr, int wc, int fr, int fq) const {
        if (u.kind == 0) {
#pragma unroll
            for (int ai = 0; ai < 2; ++ai)
#pragma unroll
                for (int m = 0; m < 4; ++m) { const int row = u.pm * 256 + ai * 128 + wr * 64 + m * 16 + fr; const float rs = rowrs(ss, row);
#pragma unroll
                    for (int bj = 0; bj < 2; ++bj) *(u32x4*)(U + (size_t)row * 512 + u.pn * 256 + bj * 128 + wc * 32 + fq * 8) = pack8(gelu4(acc[ai][bj][m][0] * rs), gelu4(acc[ai][bj][m][1] * rs)); }
        } else if (u.kind == 1) {
            const int which = u.pn >> 1, head = 4 * (u.pn & 1) + wc; bf16* O = QB + (size_t)which * ((size_t)T * 512); const float sc = which == 0 ? QSCALE : 1.0f;
            const bool rot = (which < 2) && (fq < 2);
#pragma unroll
            for (int ai = 0; ai < 2; ++ai)
#pragma unroll
                for (int m = 0; m < 4; ++m) { const int row = u.pm * 256 + ai * 128 + wr * 64 + m * 16 + fr; const float rs = rowrs(ss, row) * sc;
                    f32x4 z0 = acc[ai][0][m][0] * rs, z1 = acc[ai][0][m][1] * rs;
                    if (rot) { const f32x4* cp = (const f32x4*)(cs + (size_t)row * 16 + fq * 8); const f32x4 c0 = cp[0], c1 = cp[1];
                        f32x4 r0, r1;
                        r0[0] = z0[0] * c0[0] - z0[1] * c0[1]; r0[1] = z0[1] * c0[0] + z0[0] * c0[1]; r0[2] = z0[2] * c0[2] - z0[3] * c0[3]; r0[3] = z0[3] * c0[2] + z0[2] * c0[3];
                        r1[0] = z1[0] * c1[0] - z1[1] * c1[1]; r1[1] = z1[1] * c1[0] + z1[0] * c1[1]; r1[2] = z1[2] * c1[2] - z1[3] * c1[3]; r1[3] = z1[3] * c1[2] + z1[2] * c1[3];
                        z0 = r0; z1 = r1; }
                    *(u32x4*)(O + (size_t)row * 512 + head * 64 + fq * 8) = pack8(z0, z1);
                    *(u32x4*)(O + (size_t)row * 512 + head * 64 + 32 + fq * 8) = pack8(acc[ai][1][m][0] * rs, acc[ai][1][m][1] * rs); }
        } else {
#pragma unroll
            for (int bj = 0; bj < 2; ++bj) {
                f32x4 rc[2];
#pragma unroll
                for (int n = 0; n < 2; ++n)
#pragma unroll
                    for (int j = 0; j < 4; ++j) { rc[n][j] = rowrs(ss, u.pn * 256 + bj * 128 + wc * 32 + fq * 8 + n * 4 + j); if (j & 1) asm volatile("" ::: "memory"); }
#pragma unroll
                for (int ai = 0; ai < 2; ++ai) {
#pragma unroll
                    for (int n = 0; n < 2; ++n) {
                        f32x4 v[4];
#pragma unroll
                        for (int m = 0; m < 4; ++m) v[m] = gelu4(acc[ai][bj][m][n] * rc[n]);
#pragma unroll
                        for (int j = 0; j < 4; ++j) {
                            float s = (v[0][j] + v[1][j]) + (v[2][j] + v[3][j]); s = red16(s);
                            const float mean = s * (1.0f / 64.0f); float q = 0.f;
#pragma unroll
                            for (int m = 0; m < 4; ++m) { const float d = v[m][j] - mean; v[m][j] = d; q += d * d; }
                            q = red16(q); const float rstd = __builtin_amdgcn_rsqf(q * (1.0f / 64.0f) + LN_EPS);
#pragma unroll
                            for (int m = 0; m < 4; ++m) v[m][j] *= rstd;
                        }
#pragma unroll
                        for (int m = 0; m < 4; ++m) { const int ch = u.pm * 256 + ai * 128 + wr * 64 + m * 16 + fr; const float g = lng[ch], b = lnb[ch]; const f32x4 y = v[m] * g + b;
                            u32x2 w2; w2.x = pk2(y[0], y[1]); w2.y = pk2(y[2], y[3]);
                            *(u32x2*)(VTS + (size_t)ch * T + u.pn * 256 + bj * 128 + wc * 32 + fq * 8 + n * 4) = w2; }
                        __builtin_amdgcn_sched_barrier(0);
                    }
                }
            }
        }
    }
};
struct EpiQ {
    const float* ss; bf16* QX;
    __device__ __forceinline__ void operator()(const Acc& acc, const Unit& u, int wr, int wc, int fr, int fq) const {
#pragma unroll
        for (int ai = 0; ai < 2; ++ai)
#pragma unroll
            for (int m = 0; m < 4; ++m) { const int row = u.pm * 256 + ai * 128 + wr * 64 + m * 16 + fr; const float rs = rowrs(ss, row) * XSCALE;
#pragma unroll
                for (int bj = 0; bj < 2; ++bj) *(u32x4*)(QX + (size_t)row * DM + u.pn * 256 + bj * 128 + wc * 32 + fq * 8) = pack8(acc[ai][bj][m][0] * rs, acc[ai][bj][m][1] * rs); }
    }
};

#define XB_TMO      128
#define XB_XCNT(j)  (256  + 64 * (j))
#define XB_XSUB(j)  (1280 + 64 * (j))
#define XB_XGEN(j)  (2304 + 64 * (j))
#define XB_TOP      3328
#define XB_TOPGEN   3392
#define XCD_BAR_WORDS 3456
#define XB_SPIN_CAP (1u << 18)
__device__ __forceinline__ unsigned xb_ld(unsigned* p)              { return __hip_atomic_load(p, __ATOMIC_RELAXED, __HIP_MEMORY_SCOPE_AGENT); }
__device__ __forceinline__ unsigned xb_add(unsigned* p, unsigned v) { return __hip_atomic_fetch_add(p, v, __ATOMIC_RELAXED, __HIP_MEMORY_SCOPE_AGENT); }
__device__ __forceinline__ unsigned xb_xcc_id() { return (unsigned)__builtin_amdgcn_s_getreg((3 << 11) | 20) & 0xFu; }
#define XB_SPIN(cond, bar) do { unsigned _sp = 0; while (cond) { __builtin_amdgcn_s_sleep(1); \
    if ((++_sp & 255u) == 0u) { if (xb_ld(&(bar)[XB_TMO])) break; if (_sp > XB_SPIN_CAP) { atomicAdd(&(bar)[XB_TMO], 1u); break; } } } } while (0)
struct XcdBarrier { unsigned* bar; unsigned x; volatile LAS unsigned* st; };
__device__ __forceinline__ XcdBarrier xcd_barrier_post(unsigned* bar, volatile LAS unsigned* st) {
    XcdBarrier b; b.bar = bar; b.x = xb_xcc_id(); b.st = st;
    if (threadIdx.x == 0) (void)xb_add(&bar[XB_XCNT(b.x)], 1u);
    return b;
}
__device__ __forceinline__ void xcd_barrier_complete(unsigned* bar, unsigned x, unsigned& nloc, unsigned& nx) {
    const unsigned G = gridDim.x * gridDim.y * gridDim.z;
    unsigned sum, cnt, mine, sp = 0u;
    for (;;) {
        sum = 0u; cnt = 0u; mine = 0u;
#pragma unroll
        for (unsigned j = 0; j < 16; ++j) { const unsigned c = xb_ld(&bar[XB_XCNT(j)]); sum += c; cnt += (c > 0u) ? 1u : 0u; mine = (j == x) ? c : mine; }
        if (sum == G) break;
        __builtin_amdgcn_s_sleep(1);
        if ((++sp & 255u) == 0u) { if (xb_ld(&bar[XB_TMO])) break; if (sp > XB_SPIN_CAP) { atomicAdd(&bar[XB_TMO], 1u); break; } }
    }
    nloc = mine > 0u ? mine : 1u; nx = cnt > 0u ? cnt : 1u;
}
__device__ __forceinline__ void xcd_barrier(const XcdBarrier& b) {
    asm volatile("s_waitcnt vmcnt(0)" ::: "memory");
    __syncthreads();
    if (threadIdx.x == 0) {
        unsigned* bar = b.bar;
        __builtin_amdgcn_s_waitcnt(0);
        unsigned nloc = b.st[0], nx = b.st[1];
        if (nloc == 0u) { xcd_barrier_complete(bar, b.x, nloc, nx); b.st[0] = nloc; b.st[1] = nx; }
        const unsigned old = xb_add(&bar[XB_XSUB(b.x)], 1u);
        const unsigned gen = old / nloc;
        if (old + 1u == (gen + 1u) * nloc) {
            __builtin_amdgcn_fence(__ATOMIC_RELEASE, "agent");
            asm volatile("s_waitcnt vmcnt(0)" ::: "memory");
            const unsigned og = xb_add(&bar[XB_TOP], 1u);
            const unsigned tg = og / nx;
            if (og + 1u == (tg + 1u) * nx) xb_add(&bar[XB_TOPGEN], 1u);
            else XB_SPIN(xb_ld(&bar[XB_TOPGEN]) == tg, bar);
            __builtin_amdgcn_fence(__ATOMIC_ACQUIRE, "agent");
            xb_add(&bar[XB_XGEN(b.x)], 1u);
            asm volatile("s_waitcnt vmcnt(0)" ::: "memory");
        } else {
            XB_SPIN(xb_ld(&bar[XB_XGEN(b.x)]) == gen, bar);
            __builtin_amdgcn_fence(__ATOMIC_ACQUIRE, "agent");
            asm volatile("s_waitcnt vmcnt(0)" ::: "memory");
        }
    }
    __syncthreads();
}

struct Args { const void* in[27]; float* out; unsigned char* ws; int ph_lo, ph_hi; };
enum { I_X = 0, I_MEM, I_POS, I_F1N, I_F1G, I_F1U, I_F1D, I_MIXN, I_WIN, I_LNG, I_LNB, I_WS, I_BS, I_ONA, I_ONB, I_WOUT, I_CN, I_MN, I_WQ, I_WK, I_WV, I_WO, I_F2N, I_F2G, I_F2U, I_F2D, I_FN };

__device__ __forceinline__ void p0_transpose_item(const float* W, int K, int N, const float* gain, bf16* WT, int dst_row0, int n0, int k0, int perm, LAS float* scr, int lane) {
#pragma unroll 8
    for (int i = 0; i < 32; ++i) { const int kk = 2 * i + (lane >> 5); const float g = gain ? gain[k0 + kk] : 1.0f; scr[kk * 33 + (lane & 31)] = W[(size_t)(k0 + kk) * N + n0 + (lane & 31)] * g; }
    asm volatile("s_waitcnt lgkmcnt(0)" ::: "memory");
    const int c = lane & 7;
#pragma unroll
    for (int j = 0; j < 4; ++j) { const int n = (lane >> 3) + 8 * j; int sn = n; if (perm && n < 16) sn = (n & 1) ? (n >> 1) + 8 : (n >> 1);
        const LAS float* s = scr + (8 * c) * 33 + sn;
        u32x4 o; o.x = pk2(s[0 * 33], s[1 * 33]); o.y = pk2(s[2 * 33], s[3 * 33]); o.z = pk2(s[4 * 33], s[5 * 33]); o.w = pk2(s[6 * 33], s[7 * 33]);
        *(u32x4*)(WT + (size_t)(dst_row0 + n) * K + k0 + 8 * c) = o; }
    asm volatile("s_waitcnt lgkmcnt(0)" ::: "memory");
}
__device__ __forceinline__ void p0_wconv(const Args& a, int r, LAS float* scr, int lane) {
    unsigned char* ws = a.ws;
    const float* W; const float* gain = nullptr; bf16* WT; int K = 1024, N, n0, kb, gidx, perm = 0;
    if (r < 2816 || (r >= 8064 && r < 10880)) {
        const bool second = r >= 8064; if (second) r -= 8064;
        kb = r & 15; gidx = r >> 4; const int pn = gidx >> 3, bj = (gidx >> 2) & 1, wc = gidx & 3;
        W = (const float*)a.in[second ? (bj ? I_F2U : I_F2G) : (bj ? I_F1U : I_F1G)]; gain = (const float*)a.in[second ? I_F2N : I_F1N];
        WT = (bf16*)(ws + (second ? WS_WGU2 : WS_WGU1)); N = FF; n0 = 128 * pn + 32 * wc;
    } else if ((r >= 2816 && r < 4224) || r >= 10880) {
        const bool second = r >= 10880; r -= second ? 10880 : 2816;
        kb = r % 44; gidx = r / 44; W = (const float*)a.in[second ? I_F2D : I_F1D]; WT = (bf16*)(ws + (second ? WS_WD2 : WS_WD1)); K = FF; N = DM; n0 = 32 * gidx;
    } else if (r < 5504) {
        r -= 4224; kb = r & 15; gidx = r >> 4; const int pn = gidx >> 3;
        W = (const float*)a.in[I_WIN]; gain = (const float*)a.in[I_MIXN]; WT = (bf16*)(ws + WS_WIN); N = 2560;
        if (pn < 4) n0 = 32 * gidx;
        else { const int which = (pn - 4) >> 1, bj = (gidx >> 2) & 1, wc = gidx & 3, head = 4 * ((pn - 4) & 1) + wc; n0 = 1024 + 512 * which + 64 * head + 32 * bj; perm = (which < 2 && bj == 0) ? 1 : 0; }
    } else {
        r -= 5504; const int mid = r >> 9; r &= 511; kb = r & 15; gidx = r >> 4; N = DM; n0 = 32 * gidx;
        if (mid == 0) { W = (const float*)a.in[I_WOUT]; WT = (bf16*)(ws + WS_WOUT); gain = (kb < 8) ? (const float*)a.in[I_ONA] : (const float*)a.in[I_ONB] - 512; }
        else if (mid == 1) { W = (const float*)a.in[I_WQ]; WT = (bf16*)(ws + WS_WQ); gain = (const float*)a.in[I_CN]; }
        else if (mid == 2) { W = (const float*)a.in[I_WK]; WT = (bf16*)(ws + WS_WK); gain = (const float*)a.in[I_MN]; }
        else if (mid == 3) { W = (const float*)a.in[I_WV]; WT = (bf16*)(ws + WS_WV); gain = (const float*)a.in[I_MN]; }
        else { W = (const float*)a.in[I_WO]; WT = (bf16*)(ws + WS_WO); }
    }
    p0_transpose_item(W, K, N, gain, WT, 32 * gidx, n0, 64 * kb, perm, scr, lane);
}
__device__ __forceinline__ float row_to_bf16(const float* xrow, bf16* orow, int lane) {
    const f32x4* xr = (const f32x4*)xrow + lane; f32x4 v[4]; float s = 0.f;
#pragma unroll
    for (int j = 0; j < 4; ++j) { v[j] = xr[64 * j]; s += (v[j][0] * v[j][0] + v[j][1] * v[j][1]) + (v[j][2] * v[j][2] + v[j][3] * v[j][3]); }
    u32x2* o8 = (u32x2*)orow + lane;
#pragma unroll
    for (int j = 0; j < 4; ++j) { u32x2 w; w.x = pk2(v[j][0], v[j][1]); w.y = pk2(v[j][2], v[j][3]); o8[64 * j] = w; }
    return wave_sum(s);
}
__device__ __forceinline__ void p0_prologue(const Args& a, LAS unsigned char* lds, int vcu, int G, int wave, int lane) {
    unsigned char* ws = a.ws;
    LAS float* scr = (LAS float*)(lds + wave * 16384);
    const int gw = vcu * 8 + wave, NGW = G * 8;
    for (int it = gw; it < 12288; it += NGW) p0_wconv(a, it, scr, lane);
    const float* x = (const float*)a.in[I_X]; bf16* XB = (bf16*)(ws + WS_XB); float* SS = (float*)(ws + WS_SS);
    for (int m = gw; m < T; m += NGW) { const float s = row_to_bf16(x + (size_t)m * DM, XB + (size_t)m * DM, lane); if (lane < 16) SS[(size_t)m * 16 + lane] = lane == 0 ? s : 0.f; }
    const float* mem = (const float*)a.in[I_MEM]; bf16* MB = (bf16*)(ws + WS_MEMB); float* RSM = (float*)(ws + WS_RSM);
    for (int m = gw; m < MT; m += NGW) { const float s = row_to_bf16(mem + (size_t)m * DM, MB + (size_t)m * DM, lane); if (lane == 0) RSM[m] = __builtin_amdgcn_rsqf(s * (1.0f / 1024.0f) + NORM_EPS); }
    const int* pos = (const int*)a.in[I_POS]; f32x2* CS = (f32x2*)(ws + WS_ROPE);
    for (int idx = gw * 64 + lane; idx < T * 8; idx += NGW * 64) { const int tk = idx >> 3, i = idx & 7;
        const double invf = i == 0 ? 1.0 : i == 1 ? 0.19391225063638487 : i == 2 ? 0.037601960996863515 : i == 3 ? 0.0072914808853338354 : i == 4 ? 0.0014142135623730951 :
                            i == 5 ? 0.00027423333514461252 : i == 6 ? 5.3177203390060722e-05 : 1.0311711194248059e-05;
        const double turns = (double)pos[tk] * invf * 0.15915494309189535; const float fr = (float)(turns - __builtin_rint(turns));
        CS[idx] = (f32x2){__builtin_amdgcn_cosf(fr), __builtin_amdgcn_sinf(fr)}; }
    const float* wsrc = (const float*)a.in[I_WS]; bf16* WSB = (bf16*)(ws + WS_WSB);
    for (int idx = gw * 64 + lane; idx < 8 * 128 * 128 / 2; idx += NGW * 64) { const int e = idx * 2, j = e & 127, i = (e >> 7) & 127;
        const float v0 = j <= i ? wsrc[e] : 0.f, v1 = (j + 1) <= i ? wsrc[e + 1] : 0.f; ((unsigned*)WSB)[idx] = pk2(v0, v1); }
}

#define MFMA32(a, b, c) __builtin_amdgcn_mfma_f32_32x32x16_bf16((a), (b), (c), 0, 0, 0)
__device__ __forceinline__ bf16x8 ldg8(const bf16* p) { return *(const bf16x8*)p; }
__device__ __forceinline__ bf16x8 pack_step(const f32x16& x, int s) {
    u32x4 p; p.x = pk2(x[8 * s], x[8 * s + 1]); p.y = pk2(x[8 * s + 2], x[8 * s + 3]); p.z = pk2(x[8 * s + 4], x[8 * s + 5]); p.w = pk2(x[8 * s + 6], x[8 * s + 7]);
    return __builtin_bit_cast(bf16x8, p);
}
__device__ __forceinline__ void sgu_unit(const Args& a, int b, int ck, int g, int lane) {
    unsigned char* ws = a.ws; const int l31 = lane & 31, hh = lane >> 5, tok0 = b * SEQ + ck * 128;
    const bf16* VTS = (const bf16*)(ws + WS_VTS); const bf16* WSB = (const bf16*)(ws + WS_WSB); const bf16* U = (const bf16*)(ws + WS_U);
    bf16* YA = (bf16*)(ws + WS_YA); float* SSA = (float*)(ws + WS_SSA); const float* bs = (const float*)a.in[I_BS];
    bf16x8 af[2][8];
#pragma unroll
    for (int cb = 0; cb < 2; ++cb)
#pragma unroll
        for (int s = 0; s < 8; ++s) af[cb][s] = ldg8(VTS + (size_t)(64 * g + 32 * cb + l31) * T + tok0 + 16 * s + 8 * hh);
#pragma unroll
    for (int ib = 0; ib < 4; ++ib) {
        f32x16 c0 = {}, c1 = {};
#pragma unroll
        for (int s = 0; s < 2 * (ib + 1); ++s) { const bf16x8 bfr = ldg8(WSB + (size_t)(g * 128 + 32 * ib + l31) * 128 + 16 * s + 8 * hh);
            c0 = MFMA32(af[0][s], bfr, c0); c1 = MFMA32(af[1][s], bfr, c1); }
        const int tok = tok0 + 32 * ib + l31; const float bsv = bs[g * 128 + 32 * ib + l31]; float sq = 0.f;
#pragma unroll
        for (int cb = 0; cb < 2; ++cb)
#pragma unroll
            for (int g4 = 0; g4 < 4; ++g4) { const size_t off = (size_t)tok * 512 + 64 * g + 32 * cb + 8 * g4 + 4 * hh; const u32x2 uu = *(const u32x2*)(U + off);
                const f32x16& cc = cb ? c1 : c0;
                const float y0 = bflo(uu.x) * (cc[4 * g4] + bsv), y1 = bfhi(uu.x) * (cc[4 * g4 + 1] + bsv), y2 = bflo(uu.y) * (cc[4 * g4 + 2] + bsv), y3 = bfhi(uu.y) * (cc[4 * g4 + 3] + bsv);
                u32x2 w; w.x = pk2(y0, y1); w.y = pk2(y2, y3); *(u32x2*)(YA + off) = w; sq += (y0 * y0 + y1 * y1) + (y2 * y2 + y3 * y3); }
        sq += __shfl_xor(sq, 32);
        if (hh == 0) SSA[(size_t)tok * 8 + g] = sq;
    }
}
__device__ __forceinline__ void dil_unit(const Args& a, int set, int b, int h, int w, LAS unsigned char* vl, int lane) {
    unsigned char* ws = a.ws; const int dil = set == 0 ? 1 : (set == 1 ? 4 : 16), nqb = 64 / dil, r = w / nqb, qb = w % nqb;
    const int l31 = lane & 31, hh = lane >> 5;
    const bf16* Q = (const bf16*)(ws + WS_QB) + (size_t)b * SEQ * 512 + h * 64; const bf16* Kp = (const bf16*)(ws + WS_KB) + (size_t)b * SEQ * 512 + h * 64;
    const bf16* Vp = (const bf16*)(ws + WS_VB) + (size_t)b * SEQ * 512 + h * 64;
#define TOK(m) ((size_t)((m) * dil + r))
    bf16x8 qf[4];
#pragma unroll
    for (int s = 0; s < 4; ++s) qf[s] = ldg8(Q + TOK(32 * qb + l31) * 512 + 16 * s + 8 * hh);
    f32x16 o0 = {}, o1 = {}; float mrun = -1e30f, lrun = 0.f;
    const int li = lane & 15, q4 = li >> 2, pp = li & 3, g1 = (lane >> 4) & 1;
    const LAS unsigned char* trb = vl + (4 * hh + q4) * 128 + (16 * g1 + 4 * pp) * 2;
    for (int kt = (qb >= 4 ? qb - 4 : 0); kt <= qb; ++kt) {
        bf16x8 kf[4];
#pragma unroll
        for (int s = 0; s < 4; ++s) kf[s] = ldg8(Kp + TOK(32 * kt + l31) * 512 + 16 * s + 8 * hh);
        { const int row = lane >> 1, half = lane & 1; const bf16* src = Vp + TOK(32 * kt + row) * 512 + half * 32;
#pragma unroll
            for (int i = 0; i < 4; ++i) *(LAS u32x4*)(vl + row * 128 + half * 64 + i * 16) = *(const u32x4*)(src + i * 8); }
        f32x16 sc = {};
#pragma unroll
        for (int s = 0; s < 4; ++s) sc = MFMA32(kf[s], qf[s], sc);
        if (kt == qb) {
#pragma unroll
            for (int i = 0; i < 16; ++i) if (crow(i, hh) > l31) sc[i] = -INFINITY;
        }
        if (kt == qb - 4) {
#pragma unroll
            for (int i = 0; i < 16; ++i) if (crow(i, hh) < l31) sc[i] = -INFINITY;
        }
        float tm = sc[0];
#pragma unroll
        for (int i = 1; i < 16; ++i) tm = fmaxf(tm, sc[i]);
        tm = fmaxf(tm, __shfl_xor(tm, 32));
        const float mnew = fmaxf(mrun, tm), alpha = __builtin_amdgcn_exp2f(mrun - mnew); mrun = mnew;
        float ps = 0.f;
#pragma unroll
        for (int i = 0; i < 16; ++i) { sc[i] = __builtin_amdgcn_exp2f(sc[i] - mnew); ps += sc[i]; }
        lrun = lrun * alpha + ps;
#pragma unroll
        for (int i = 0; i < 16; ++i) { o0[i] *= alpha; o1[i] *= alpha; }
        const bf16x8 p0 = pack_step(sc, 0), p1 = pack_step(sc, 1);
        asm volatile("s_waitcnt lgkmcnt(0)" ::: "memory");
#pragma unroll
        for (int db = 0; db < 2; ++db)
#pragma unroll
            for (int s = 0; s < 2; ++s) {
                const v4i16_t lo = __builtin_amdgcn_ds_read_tr16_b64_v4i16((LAS v4i16_t*)(trb + s * 2048 + db * 64));
                const v4i16_t hi = __builtin_amdgcn_ds_read_tr16_b64_v4i16((LAS v4i16_t*)(trb + s * 2048 + 1024 + db * 64));
                const bf16x8 vf = (bf16x8){lo[0], lo[1], lo[2], lo[3], hi[0], hi[1], hi[2], hi[3]};
                if (db == 0) o0 = MFMA32(vf, s ? p1 : p0, o0); else o1 = MFMA32(vf, s ? p1 : p0, o1);
            }
        asm volatile("s_waitcnt lgkmcnt(0)" ::: "memory");
    }
    const float lt = lrun + __shfl_xor(lrun, 32), inv = __builtin_amdgcn_rcpf(lt);
    const size_t tokq = (size_t)b * SEQ + TOK(32 * qb + l31);
    bf16* OG = (bf16*)(ws + WS_OG) + (size_t)set * T * 512 + tokq * 512 + h * 64;
#pragma unroll
    for (int db = 0; db < 2; ++db)
#pragma unroll
        for (int g4 = 0; g4 < 4; ++g4) { const f32x16& oo = db ? o1 : o0; u32x2 w2; w2.x = pk2(oo[4 * g4] * inv, oo[4 * g4 + 1] * inv); w2.y = pk2(oo[4 * g4 + 2] * inv, oo[4 * g4 + 3] * inv);
            *(u32x2*)(OG + 32 * db + 8 * g4 + 4 * hh) = w2; }
    if (hh == 0) ((float*)(ws + WS_LSE))[(size_t)set * T * 8 + tokq * 8 + h] = mrun + __builtin_amdgcn_logf(lt);
#undef TOK
}

constexpr int XQ_PITCH = 528;
__device__ __forceinline__ void xattn_unit(const Args& a, int b, int head, int qb, LAS unsigned char* ql, int lane) {
    unsigned char* ws = a.ws; const int l31 = lane & 31, hh = lane >> 5;
    const bf16* QX = (const bf16*)(ws + WS_QX) + ((size_t)b * SEQ + 32 * qb) * DM + head * 256;
    const bf16* KC = (const bf16*)(ws + WS_KC) + (size_t)b * NMEM * DM + head * 256;
    const bf16* VT = (const bf16*)(ws + WS_VT) + (size_t)head * 256 * MT + b * NMEM;
#pragma unroll
    for (int i = 0; i < 16; ++i) { const int idx = i * 64 + lane, row = idx >> 5, ch = idx & 31; *(LAS u32x4*)(ql + row * XQ_PITCH + ch * 16) = *(const u32x4*)(QX + (size_t)row * DM + ch * 8); }
    asm volatile("s_waitcnt vmcnt(0) lgkmcnt(0)" ::: "memory");
    f32x16 o[8];
#pragma unroll
    for (int d = 0; d < 8; ++d) o[d] = (f32x16){};
    float mrun = -1e30f, lrun = 0.f;
    const int krow = (l31 & ~12) | ((l31 & 4) << 1) | ((l31 & 8) >> 1);
    const LAS unsigned char* qrd = ql + l31 * XQ_PITCH + hh * 16;
    for (int kt = 0; kt < 8; ++kt) {
        asm volatile("" ::: "memory");
        f32x16 sc = {};
        const bf16* kr = KC + (size_t)(32 * kt + krow) * DM + 8 * hh;
#pragma unroll
        for (int s = 0; s < 16; ++s) sc = MFMA32(ldg8(kr + 16 * s), *(const LAS bf16x8*)(qrd + s * 32), sc);
        float tm = sc[0];
#pragma unroll
        for (int i = 1; i < 16; ++i) tm = fmaxf(tm, sc[i]);
        tm = fmaxf(tm, __shfl_xor(tm, 32));
        const float mnew = fmaxf(mrun, tm), alpha = __builtin_amdgcn_exp2f(mrun - mnew); mrun = mnew;
        float ps = 0.f;
#pragma unroll
        for (int i = 0; i < 16; ++i) { sc[i] = __builtin_amdgcn_exp2f(sc[i] - mnew); ps += sc[i]; }
        lrun = lrun * alpha + ps;
        const bf16x8 p0 = pack_step(sc, 0), p1 = pack_step(sc, 1);
#pragma unroll
        for (int d = 0; d < 8; ++d) {
#pragma unroll
            for (int i = 0; i < 16; ++i) o[d][i] *= alpha;
            const bf16* vr = VT + (size_t)(32 * d + l31) * MT + 32 * kt + 8 * hh;
            o[d] = MFMA32(ldg8(vr), p0, o[d]); o[d] = MFMA32(ldg8(vr + 16), p1, o[d]);
        }
    }
    const float lt = lrun + __shfl_xor(lrun, 32), inv = __builtin_amdgcn_rcpf(lt);
    bf16* OX = (bf16*)(ws + WS_OX) + ((size_t)b * SEQ + 32 * qb + l31) * DM + head * 256;
#pragma unroll
    for (int d = 0; d < 8; ++d)
#pragma unroll
        for (int g4 = 0; g4 < 4; ++g4) { u32x2 w2; w2.x = pk2(o[d][4 * g4] * inv, o[d][4 * g4 + 1] * inv); w2.y = pk2(o[d][4 * g4 + 2] * inv, o[d][4 * g4 + 3] * inv);
            *(u32x2*)(OX + 32 * d + 8 * g4 + 4 * hh) = w2; }
}

constexpr size_t TS1024 = (size_t)256 * 1024 * 2, TS2816 = (size_t)256 * FF * 2;
struct DP1 { static constexpr size_t tstep = TS1024, A0 = WS_XB, B0 = WS_WGU1, A1 = WS_MEMB, B1 = WS_WK, A2 = WS_WV, B2 = WS_MEMB; static constexpr int nM0 = 64, nN0 = 22, n0 = 1408, nM1 = 8, nN1 = 4, n1 = 32, nM2 = 4, nN2 = 8, n2 = 32; };
struct DP2 { static constexpr size_t tstep = TS2816, A0 = WS_ACT, B0 = WS_WD1, A1 = 0, B1 = 0, A2 = 0, B2 = 0; static constexpr int nM0 = 64, nN0 = 4, n0 = 256, nM1 = 1, nN1 = 1, n1 = 0, nM2 = 1, nN2 = 1, n2 = 0; };
struct DP3 { static constexpr size_t tstep = TS1024, A0 = WS_XB, B0 = WS_WIN, A1 = WS_XB, B1 = WS_WIN + (size_t)1024 * 1024 * 2, A2 = WS_WIN + (size_t)512 * 1024 * 2, B2 = WS_XB; static constexpr int nM0 = 64, nN0 = 2, n0 = 128, nM1 = 64, nN1 = 6, n1 = 384, nM2 = 2, nN2 = 64, n2 = 128; };
struct DP6 { static constexpr size_t tstep = TS1024, A0 = WS_Y, B0 = WS_WOUT, A1 = 0, B1 = 0, A2 = 0, B2 = 0; static constexpr int nM0 = 64, nN0 = 4, n0 = 256, nM1 = 1, nN1 = 1, n1 = 0, nM2 = 1, nN2 = 1, n2 = 0; };
struct DP7 { static constexpr size_t tstep = TS1024, A0 = WS_XB, B0 = WS_WQ, A1 = 0, B1 = 0, A2 = 0, B2 = 0; static constexpr int nM0 = 64, nN0 = 4, n0 = 256, nM1 = 1, nN1 = 1, n1 = 0, nM2 = 1, nN2 = 1, n2 = 0; };
struct DP9 { static constexpr size_t tstep = TS1024, A0 = WS_OX, B0 = WS_WO, A1 = 0, B1 = 0, A2 = 0, B2 = 0; static constexpr int nM0 = 64, nN0 = 4, n0 = 256, nM1 = 1, nN1 = 1, n1 = 0, nM2 = 1, nN2 = 1, n2 = 0; };
struct DP10 { static constexpr size_t tstep = TS1024, A0 = WS_XB, B0 = WS_WGU2, A1 = 0, B1 = 0, A2 = 0, B2 = 0; static constexpr int nM0 = 64, nN0 = 22, n0 = 1408, nM1 = 1, nN1 = 1, n1 = 0, nM2 = 1, nN2 = 1, n2 = 0; };
struct DP11 { static constexpr size_t tstep = TS2816, A0 = WS_ACT, B0 = WS_WD2, A1 = 0, B1 = 0, A2 = 0, B2 = 0; static constexpr int nM0 = 64, nN0 = 4, n0 = 256, nM1 = 1, nN1 = 1, n1 = 0, nM2 = 1, nN2 = 1, n2 = 0; };

__global__ void __launch_bounds__(512, 2) mk_fwd(Args args) {
    extern __shared__ __attribute__((aligned(16))) unsigned char lds_raw[];
    LAS unsigned char* lds = (LAS unsigned char*)lds_raw;
    const int tid = threadIdx.x, lane = tid & 63, wave = __builtin_amdgcn_readfirstlane(tid >> 6);
    const int G = gridDim.x, bx = blockIdx.x, vcu = (G % 8 == 0) ? (bx % 8) * (G / 8) + bx / 8 : bx;
    unsigned char* ws = args.ws;
    const int gw = vcu * 8 + wave, NGW = G * 8;
    const int lo = args.ph_lo, hi = args.ph_hi;
#if !MK_PER_PHASE
    volatile LAS unsigned* MISC = (volatile LAS unsigned*)(lds + MISC_OFF);
    for (int u = tid; u < (LDS_BYTES - LDSCTL_OFF) / 4; u += 512) ((LAS unsigned*)(lds + LDSCTL_OFF))[u] = 0u;
    __syncthreads();
    XcdBarrier bar = xcd_barrier_post((unsigned*)(ws + WS_CTL) + CW_BAR, MISC + 8);
#define GRID_BAR() xcd_barrier(bar)
#else
#define GRID_BAR() do { } while (0)
#endif
#define IN(k) (lo <= (k) && (k) < hi)
#define SEAM(k) do { if (IN((k) + 1)) GRID_BAR(); } while (0)
    float* out = args.out;
    bf16* XB = (bf16*)(ws + WS_XB); float* SS = (float*)(ws + WS_SS);

    if (IN(0)) { p0_prologue(args, lds, vcu, G, wave, lane); SEAM(0); }

    if (IN(1)) {
        pg8::MultiSched<DP1> S{(const char*)ws, G, bx};
        EpiP1 E{(bf16*)(ws + WS_ACT), SS, (bf16*)(ws + WS_KC), (bf16*)(ws + WS_VT), (const float*)(ws + WS_RSM)};
        pg8::gemm_phase(lds, 1024, S, E); SEAM(1);
    }
    if (IN(2)) {
        pg8::MultiSched<DP2> S{(const char*)ws, G, bx};
        EpiRes E{(const float*)args.in[I_X], out, XB, SS, 0.5f};
        pg8::gemm_phase(lds, FF, S, E); SEAM(2);
    }
    if (IN(3)) {
        pg8::MultiSched<DP3> S{(const char*)ws, G, bx};
        EpiP3 E{SS, (bf16*)(ws + WS_U), (bf16*)(ws + WS_QB), (const float*)(ws + WS_ROPE), (bf16*)(ws + WS_VTS), (const float*)args.in[I_LNG], (const float*)args.in[I_LNB]};
        pg8::gemm_phase(lds, 1024, S, E); SEAM(3);
    }
    if (IN(4)) {
        LAS unsigned char* vl = lds + wave * 8192;
        for (int uid = gw; uid < 12288 + 1024; uid += NGW) {
            if (uid < 12288) { const int w = uid & 63, h = (uid >> 6) & 7, b = (uid >> 9) & 7, set = uid >> 12; dil_unit(args, set, b, h, w, vl, lane); }
            else { const int v = uid - 12288; sgu_unit(args, v >> 7, (v >> 3) & 15, v & 7, lane); }
        }
        SEAM(4);
    }
    if (IN(5)) {
        const bf16* YA = (const bf16*)(ws + WS_YA); const float* SSA = (const float*)(ws + WS_SSA); const float* LSE = (const float*)(ws + WS_LSE); const bf16* OG = (const bf16*)(ws + WS_OG);
        bf16* Y = (bf16*)(ws + WS_Y);
        for (int row = gw; row < T; row += NGW) {
            const int c0 = 8 * lane, head = lane >> 3;
            const f32x4 s0 = *(const f32x4*)(SSA + (size_t)row * 8), s1 = *(const f32x4*)(SSA + (size_t)row * 8 + 4);
            const float rsa = __builtin_amdgcn_rsqf((((s0[0] + s0[1]) + (s0[2] + s0[3])) + ((s1[0] + s1[1]) + (s1[2] + s1[3]))) * (1.0f / 512.0f) + NORM_EPS);
            const u32x4 ya = *(const u32x4*)(YA + (size_t)row * 512 + c0);
            const float l0 = LSE[(size_t)row * 8 + head], l1 = LSE[(size_t)T * 8 + (size_t)row * 8 + head], l2 = LSE[(size_t)2 * T * 8 + (size_t)row * 8 + head];
            const float mx = fmaxf(l0, fmaxf(l1, l2)); float w0 = __builtin_amdgcn_exp2f(l0 - mx), w1 = __builtin_amdgcn_exp2f(l1 - mx), w2 = __builtin_amdgcn_exp2f(l2 - mx);
            const float wi = __builtin_amdgcn_rcpf(w0 + w1 + w2); w0 *= wi; w1 *= wi; w2 *= wi;
            const u32x4 g0 = *(const u32x4*)(OG + (size_t)row * 512 + c0), g1 = *(const u32x4*)(OG + (size_t)T * 512 + (size_t)row * 512 + c0), g2 = *(const u32x4*)(OG + (size_t)2 * T * 512 + (size_t)row * 512 + c0);
            float yb[8]; float sq = 0.f;
#pragma unroll
            for (int k = 0; k < 4; ++k) { yb[2 * k] = w0 * bflo(g0[k]) + w1 * bflo(g1[k]) + w2 * bflo(g2[k]); yb[2 * k + 1] = w0 * bfhi(g0[k]) + w1 * bfhi(g1[k]) + w2 * bfhi(g2[k]); sq += yb[2 * k] * yb[2 * k] + yb[2 * k + 1] * yb[2 * k + 1]; }
            const float rsb = __builtin_amdgcn_rsqf(wave_sum(sq) * (1.0f / 512.0f) + NORM_EPS);
            u32x4 oa, ob;
#pragma unroll
            for (int k = 0; k < 4; ++k) { oa[k] = pk2(bflo(ya[k]) * rsa, bfhi(ya[k]) * rsa); ob[k] = pk2(yb[2 * k] * rsb, yb[2 * k + 1] * rsb); }
            *(u32x4*)(Y + (size_t)row * DM + c0) = oa; *(u32x4*)(Y + (size_t)row * DM + 512 + c0) = ob;
        }
        SEAM(5);
    }
    if (IN(6)) {
        pg8::MultiSched<DP6> S{(const char*)ws, G, bx};
        EpiRes E{out, out, XB, SS, 1.0f};
        pg8::gemm_phase(lds, 1024, S, E); SEAM(6);
    }
    if (IN(7)) {
        pg8::MultiSched<DP7> S{(const char*)ws, G, bx};
        EpiQ E{SS, (bf16*)(ws + WS_QX)};
        pg8::gemm_phase(lds, 1024, S, E); SEAM(7);
    }
    if (IN(8)) {
        LAS unsigned char* ql = lds + wave * (32 * XQ_PITCH);
        for (int uid = gw; uid < 2048; uid += NGW) xattn_unit(args, uid >> 8, (uid >> 6) & 3, uid & 63, ql, lane);
        SEAM(8);
    }
    if (IN(9)) {
        pg8::MultiSched<DP9> S{(const char*)ws, G, bx};
        EpiRes E{out, out, XB, SS, 1.0f};
        pg8::gemm_phase(lds, 1024, S, E); SEAM(9);
    }
    if (IN(10)) {
        pg8::MultiSched<DP10> S{(const char*)ws, G, bx};
        EpiP1 E{(bf16*)(ws + WS_ACT), SS, nullptr, nullptr, nullptr};
        pg8::gemm_phase(lds, 1024, S, E); SEAM(10);
    }
    if (IN(11)) {
        pg8::MultiSched<DP11> S{(const char*)ws, G, bx};
        EpiRes E{out, out, nullptr, SS, 0.5f};
        pg8::gemm_phase(lds, FF, S, E); SEAM(11);
    }
    if (IN(12)) {
        const float* gf = (const float*)args.in[I_FN];
        for (int row = gw; row < T; row += NGW) { const float rs = rowrs(SS, row); f32x4* xr = (f32x4*)(out + (size_t)row * DM) + lane; const f32x4* gr = (const f32x4*)gf + lane;
#pragma unroll
            for (int j = 0; j < 4; ++j) xr[64 * j] = xr[64 * j] * rs * gr[64 * j]; }
    }
#undef IN
#undef SEAM
}

#if MK_DEBUG
#include "dbg_checks.inc"
#endif

extern "C" void kernel_launch(void* const* d_in, const int* in_sizes, int n_in, void* d_out, int out_size, void* d_ws, size_t ws_size, hipStream_t stream) {
    static int grid = 0;
    if (grid == 0) {
        if (n_in != 27 || out_size != T * DM || ws_size < WS_END) { fprintf(stderr, "kernel_launch: unexpected shapes (n_in %d out %d ws %zu)\n", n_in, out_size, ws_size); grid = -1; return; }
        int dev = 0, cus = 0, per_cu = 0;
        if (hipGetDevice(&dev) != hipSuccess || hipDeviceGetAttribute(&cus, hipDeviceAttributeMultiprocessorCount, dev) != hipSuccess) { grid = -1; return; }
        if (hipFuncSetAttribute((const void*)mk_fwd, hipFuncAttributeMaxDynamicSharedMemorySize, LDS_BYTES) != hipSuccess) { fprintf(stderr, "kernel_launch: hipFuncSetAttribute failed\n"); grid = -1; return; }
        if (hipOccupancyMaxActiveBlocksPerMultiprocessor(&per_cu, (const void*)mk_fwd, 512, LDS_BYTES) != hipSuccess || per_cu < 1) { fprintf(stderr, "kernel_launch: occupancy query says %d\n", per_cu); per_cu = 1; }
        (void)hipGetLastError();
        grid = cus * (per_cu < 1 ? per_cu : 1);
    }
    if (grid < 0) return;
    (void)hipMemsetAsync((char*)d_ws + WS_CTL, 0, CTL_ZERO_BYTES, stream);
    Args a{};
    for (int i = 0; i < 27; ++i) a.in[i] = d_in[i];
    a.out = (float*)d_out; a.ws = (unsigned char*)d_ws;
#if MK_PER_PHASE
    for (int ph = 0; ph < NPH; ++ph) {
        a.ph_lo = ph; a.ph_hi = ph + 1;
#if MK_DEBUG
        dbg_before(a, ph, stream);
#endif
        hipLaunchKernelGGL(mk_fwd, dim3(grid), dim3(512), LDS_BYTES, stream, a);
#if MK_DEBUG
        dbg_after(a, ph, stream);
#endif
    }
#if MK_DEBUG
    dbg_encode(a, stream);
#endif
#else
    a.ph_lo = 0; a.ph_hi = NPH;
    void* kargs[] = {&a};
    hipError_t e = hipLaunchCooperativeKernel((const void*)mk_fwd, dim3(grid), dim3(512), kargs, LDS_BYTES, stream);
    if (e != hipSuccess) fprintf(stderr, "kernel_launch: cooperative launch failed: %s (grid %d)\n", hipGetErrorString(e), grid);
#endif
}
```

```cpp
#include <hip/hip_runtime.h>
#include <cstdio>
#include <cstdint>

#ifndef MK_PER_PHASE
#define MK_PER_PHASE 0
#endif
#ifndef MK_TIMING
#define MK_TIMING 0
#endif
#ifndef PROBE_A
#define PROBE_A 0
#endif
#ifndef PROBE_B
#define PROBE_B 1
#endif
#ifndef PROBE_DUP
#define PROBE_DUP -1
#endif
#define REP(k) for (int rep_ = 0; rep_ < ((PROBE_DUP == (k) || ((k) == 4 && PROBE_DUP >= 40 && PROBE_DUP < 50)) ? 2 : 1); ++rep_)
#ifndef MK_COOP
#define MK_COOP 1
#endif
#ifndef MK_DEBUG
#define MK_DEBUG 0
#endif

#if MK_TIMING
#define STAMP0() do { if (threadIdx.x == 0) MISC[16] = (unsigned)__builtin_amdgcn_s_memrealtime(); } while (0)
#else
#define STAMP0() do { } while (0)
#endif
#define LAS __attribute__((address_space(3)))
#define GAS __attribute__((address_space(1)))
typedef unsigned short bf16;
typedef short bf16x8 __attribute__((ext_vector_type(8)));
typedef float f32x4 __attribute__((ext_vector_type(4)));
typedef float f32x2 __attribute__((ext_vector_type(2)));
typedef float f32x16 __attribute__((ext_vector_type(16)));
typedef unsigned u32x4 __attribute__((ext_vector_type(4)));
typedef unsigned u32x2 __attribute__((ext_vector_type(2)));
typedef __bf16 bf16x2_t __attribute__((ext_vector_type(2)));
typedef short v4i16_t __attribute__((ext_vector_type(4)));

constexpr int BATCH = 8, SEQ = 2048, T = BATCH * SEQ, DM = 1024, FF = 2816, NMEM = 256, MT = BATCH * NMEM;
constexpr int NPH = 13;
constexpr float QSCALE = 0.125f * 1.4426950408889634f;
constexpr float XSCALE = 0.0625f * 1.4426950408889634f;
constexpr float NORM_EPS = 1e-6f, LN_EPS = 1e-5f;

constexpr size_t MiB = 1u << 20;
constexpr size_t WS_CTL = 0, CTL_ZERO_BYTES = 1 * MiB;
constexpr size_t WS_WGU1 = 1 * MiB, WS_WD1 = 12 * MiB, WS_WIN = 18 * MiB, WS_WOUT = 23 * MiB, WS_WQ = 25 * MiB, WS_WK = 27 * MiB, WS_WV = 29 * MiB,
                 WS_WO = 31 * MiB, WS_WGU2 = 33 * MiB, WS_WD2 = 44 * MiB;
constexpr size_t WS_WSB = 50 * MiB;
constexpr size_t WS_ROPE = 50 * MiB + 512 * 1024;
constexpr size_t WS_SS = 52 * MiB;
constexpr size_t WS_RSM = 53 * MiB;
constexpr size_t WS_SSA = 53 * MiB + 512 * 1024;
constexpr size_t WS_LSE = 54 * MiB;
constexpr size_t WS_MEMB = 56 * MiB, WS_KC = 60 * MiB, WS_VT = 64 * MiB;
constexpr size_t WS_XB = 68 * MiB;
constexpr size_t WS_R = 100 * MiB;
constexpr size_t WS_ACT = WS_R;
constexpr size_t WS_U = WS_R, WS_VTS = WS_R + 16 * MiB, WS_QB = WS_R + 32 * MiB, WS_KB = WS_R + 48 * MiB, WS_VB = WS_R + 64 * MiB,
                 WS_YA = WS_R + 80 * MiB, WS_OG = WS_R + 96 * MiB;
constexpr size_t WS_Y = WS_R;
constexpr size_t WS_QX = WS_R + 32 * MiB, WS_OX = WS_R + 64 * MiB;
constexpr size_t WS_END = 256 * MiB;
static_assert(WS_OG + 48 * MiB <= WS_END && WS_KB == WS_QB + 16 * MiB && WS_VB == WS_KB + 16 * MiB, "ws map");

constexpr int CW_BAR = 4096;
constexpr int CW_DBG = 65536;

constexpr int RING_BYTES = 131072;
constexpr int LDSCTL_OFF = 139264, MISC_OFF = LDSCTL_OFF + 320;
constexpr int LDS_BYTES = 147456;

__device__ __forceinline__ unsigned pk2(float lo, float hi) { f32x2 v = {lo, hi}; bf16x2_t b = __builtin_convertvector(v, bf16x2_t); return __builtin_bit_cast(unsigned, b); }
__device__ __forceinline__ float bf2f(bf16 v) { return __uint_as_float((unsigned)v << 16); }
__device__ __forceinline__ float bflo(unsigned w) { return __uint_as_float(w << 16); }
__device__ __forceinline__ float bfhi(unsigned w) { return __uint_as_float(w & 0xffff0000u); }
__device__ __forceinline__ u32x4 pack8(f32x4 a, f32x4 b) { u32x4 w; w.x = pk2(a[0], a[1]); w.y = pk2(a[2], a[3]); w.z = pk2(b[0], b[1]); w.w = pk2(b[2], b[3]); return w; }
__device__ __forceinline__ float wave_sum(float v) {
#pragma unroll
    for (int o = 1; o < 64; o <<= 1) v += __shfl_xor(v, o);
    return v;
}
__device__ __forceinline__ float red16(float v) {
    v += __shfl_xor(v, 1); v += __shfl_xor(v, 2); v += __shfl_xor(v, 4); v += __shfl_xor(v, 8); return v;
}
__device__ __forceinline__ int crow(int r, int hi) { return (r & 3) + 8 * (r >> 2) + 4 * hi; }
__device__ __forceinline__ float rowrs(const float* ss, int row) {
    const f32x4* p = (const f32x4*)(ss + (size_t)row * 16);
    const f32x4 s = (p[0] + p[1]) + (p[2] + p[3]);
    return __builtin_amdgcn_rsqf(((s[0] + s[1]) + (s[2] + s[3])) * (1.0f / 1024.0f) + NORM_EPS);
}
__device__ __forceinline__ f32x2 gelu_pk(f32x2 v) {
    const f32x2 av = __builtin_elementwise_abs(v), d = av * 0.2316418882f + 1.0f;
    f32x2 t; t.x = __builtin_amdgcn_rcpf(d.x); t.y = __builtin_amdgcn_rcpf(d.y);
    f32x2 q = t * 0.5307027145f + (-0.7265760135f); q = q * t + 0.7107068705f; q = q * t + (-0.142248368f); q = q * t + 0.127414796f; q = q * t;
    const f32x2 s = (v * v) * (-0.72134752044f);
    f32x2 e; e.x = __builtin_amdgcn_exp2f(s.x); e.y = __builtin_amdgcn_exp2f(s.y);
    const f32x2 m = v * (q * e), r = v - m;
    f32x2 o; o.x = v.x < 0.f ? m.x : r.x; o.y = v.y < 0.f ? m.y : r.y; return o;
}
__device__ __forceinline__ f32x4 gelu4(f32x4 v) { f32x2 a = gelu_pk((f32x2){v[0], v[1]}), b = gelu_pk((f32x2){v[2], v[3]}); return (f32x4){a.x, a.y, b.x, b.y}; }
__device__ __forceinline__ float silu1(float g) { return g * __builtin_amdgcn_rcpf(1.0f + __builtin_amdgcn_exp2f(-1.4426950408889634f * g)); }

namespace pg8 {
constexpr int BM = 256, BK = 64, HALF = 128, HTB = HALF * BK * 2, STAGE_BYTES = 8 * HTB, NXCD = 8;
__host__ __device__ __forceinline__ int lds_byte(int r, int c) { const int st = (r >> 4) * 2 + (c >> 5), rr = r & 15, cc = c & 31, ob = rr * 64 + cc * 2; return st * 1024 + (ob ^ (((ob >> 9) & 1) << 5)); }
__host__ __device__ __forceinline__ void stage_rc(int b, int& R, int& C) { const int st = b / 1024, sb = b % 1024, swz = sb ^ (((sb >> 9) & 1) << 5); R = (st >> 1) * 16 + swz / 64; C = (st & 1) * 32 + (swz % 64) / 2; }
__host__ __device__ __forceinline__ int perm32(int rho) { const int n = rho >> 4, i = rho & 15; return 8 * (i >> 2) + 4 * n + (i & 3); }

struct Unit { const char* a; const char* b; int pm, pn, kind; };

template <class Epi, class Sched>
__device__ __forceinline__ void gemm_phase(LAS unsigned char* lds, const int K, const Sched& S, const Epi& E) {
    const int tid = threadIdx.x, wid = __builtin_amdgcn_readfirstlane(tid >> 6), lane = tid & 63, wr = wid >> 2, wc = wid & 3, fr = lane & 15, fq = lane >> 4;
    const int nt = K / BK;
    unsigned voffA[2], voffB[2];
#pragma unroll
    for (int i = 0; i < 2; ++i) { int R, C; stage_rc(tid * 16 + i * 8192, R, C); const int Rb = (R & ~31) + perm32(R & 31);
        voffA[i] = (unsigned)(R * K + C) * 2u; voffB[i] = (unsigned)(Rb * K + C) * 2u; }
    const size_t kstep = (size_t)(BK * 2);
    const size_t hstep = (size_t)HALF * K * 2;
    const unsigned ldsw = (unsigned)wid * 1024u;
    const int aoff = lds_byte(wr * 64 + fr, fq * 8), boff = lds_byte(wc * 32 + fr, fq * 8);
#define PG8_SA(b, h) (((b) * 2 + (h)) * HTB)
#define PG8_SB(b, h) ((4 + (b) * 2 + (h)) * HTB)
#define PG8_STAGE(bufoff, gbase, voff) do { _Pragma("unroll") for (int _i = 0; _i < 2; ++_i) \
        __builtin_amdgcn_global_load_lds((const unsigned*)((const char*)(gbase) + (voff)[_i]), (LAS unsigned*)(lds + (bufoff) + ldsw + _i * 8192), 16, 0, 0); } while (0)
#define PG8_LDA(dst, b, h) do { _Pragma("unroll") for (int m = 0; m < 4; ++m) _Pragma("unroll") for (int k = 0; k < 2; ++k) dst[m][k] = *(const LAS bf16x8*)(lds + PG8_SA(b, h) + aoff + m * 2048 + k * 1024); } while (0)
#define PG8_LDB(dst, b, h) do { _Pragma("unroll") for (int n = 0; n < 2; ++n) _Pragma("unroll") for (int k = 0; k < 2; ++k) dst[n][k] = *(const LAS bf16x8*)(lds + PG8_SB(b, h) + boff + n * 2048 + k * 1024); } while (0)
#define PG8_MMA(ai, bj, At, Bt) do { __builtin_amdgcn_s_setprio(1); _Pragma("unroll") for (int m = 0; m < 4; ++m) _Pragma("unroll") for (int n = 0; n < 2; ++n) _Pragma("unroll") for (int k = 0; k < 2; ++k) \
        acc[ai][bj][m][n] = __builtin_amdgcn_mfma_f32_16x16x32_bf16(Bt[n][k], At[m][k], acc[ai][bj][m][n], 0, 0, 0); __builtin_amdgcn_s_setprio(0); } while (0)
#define PG8_WAIT_V(n) asm volatile("s_waitcnt vmcnt(" #n ")" ::: "memory")
#define PG8_WAIT_L(n) asm volatile("s_waitcnt lgkmcnt(" #n ")" ::: "memory")
#define PG8_BAR __builtin_amdgcn_s_barrier()
#define PG8_SCHED __builtin_amdgcn_sched_barrier(0)
    Unit cur, nxt; int ui = 0;
    if (!S.next(0, cur)) return;
    f32x4 acc[2][2][4][2];
    bf16x8 At[4][2], B0[2][2], B1[2][2];
    const char* cA = cur.a; const char* cB = cur.b;
    PG8_STAGE(PG8_SB(0, 0), cB, voffB); PG8_STAGE(PG8_SB(0, 1), cB + hstep, voffB); PG8_STAGE(PG8_SA(0, 0), cA, voffA); PG8_STAGE(PG8_SA(0, 1), cA + hstep, voffA);
    if (wr == 1) PG8_BAR;
    PG8_WAIT_V(2); PG8_BAR;
    PG8_STAGE(PG8_SB(1, 0), cB + kstep, voffB); PG8_STAGE(PG8_SA(1, 0), cA + kstep, voffA); PG8_STAGE(PG8_SB(1, 1), cB + hstep + kstep, voffB);
    E.init(acc, cur, wr, wc, fr, fq);
    if constexpr (Epi::INIT_LOADS == 0) { PG8_WAIT_V(6); } else { static_assert(Epi::INIT_LOADS == 32, "counted wait"); PG8_WAIT_V(38); }
    PG8_BAR;
    for (;;) {
        const bool has_next = S.next(ui + 1, nxt);
        const char* nA = has_next ? nxt.a : cA; const char* nB = has_next ? nxt.b : cB;
        for (int t = 0; t < nt; t += 2) {
            const bool last = (t == nt - 2);
            const char* a1 = cA + (size_t)(t + 1) * kstep;
            const char* a2 = last ? nA : cA + (size_t)(t + 2) * kstep; const char* b2 = last ? nB : cB + (size_t)(t + 2) * kstep;
            const char* a3 = a2 + kstep; const char* b3 = b2 + kstep;
            PG8_LDB(B0, 0, 0); PG8_LDB(B1, 0, 1); PG8_SCHED; PG8_LDA(At, 0, 0); PG8_STAGE(PG8_SA(1, 1), a1 + hstep, voffA);
            PG8_WAIT_V(8); PG8_WAIT_L(0); PG8_BAR; PG8_MMA(0, 0, At, B0); PG8_MMA(0, 1, At, B1); PG8_BAR; PG8_SCHED;
            PG8_LDA(At, 0, 1); PG8_STAGE(PG8_SB(0, 0), b2, voffB); PG8_STAGE(PG8_SB(0, 1), b2 + hstep, voffB); PG8_STAGE(PG8_SA(0, 0), a2, voffA);
            PG8_WAIT_V(8); PG8_WAIT_L(0); PG8_BAR; PG8_MMA(1, 0, At, B0); PG8_MMA(1, 1, At, B1); PG8_BAR; PG8_SCHED;
            PG8_LDB(B0, 1, 0); PG8_LDB(B1, 1, 1); PG8_SCHED; PG8_LDA(At, 1, 0); PG8_STAGE(PG8_SA(0, 1), a2 + hstep, voffA);
            PG8_WAIT_V(8); PG8_WAIT_L(0); PG8_BAR; PG8_MMA(0, 0, At, B0); PG8_MMA(0, 1, At, B1); PG8_BAR; PG8_SCHED;
            PG8_LDA(At, 1, 1); PG8_STAGE(PG8_SB(1, 0), b3, voffB); PG8_STAGE(PG8_SB(1, 1), b3 + hstep, voffB); PG8_STAGE(PG8_SA(1, 0), a3, voffA);
            PG8_WAIT_V(8); PG8_WAIT_L(0); PG8_BAR; PG8_MMA(1, 0, At, B0); PG8_MMA(1, 1, At, B1); PG8_BAR; PG8_SCHED;
        }
        if (wr == 0) PG8_BAR;
        { int fr2 = fr, fq2 = fq; asm volatile("" : "+v"(fr2), "+v"(fq2)); E(acc, cur, wr, wc, fr2, fq2); }
        if (!has_next) break;
        cur = nxt; cA = nA; cB = nB; ++ui;
        E.init(acc, cur, wr, wc, fr, fq);
        if (wr == 1) PG8_BAR;
    }
    PG8_WAIT_V(0);
    PG8_BAR;
#undef PG8_SA
#undef PG8_SB
#undef PG8_STAGE
#undef PG8_LDA
#undef PG8_LDB
#undef PG8_MMA
#undef PG8_WAIT_V
#undef PG8_WAIT_L
#undef PG8_BAR
#undef PG8_SCHED
}

template <class D> struct MultiSched {
    const char* base; int G, c;
    static constexpr int nwg = D::n0 + D::n1 + D::n2;
    template <int nM, int nN> __device__ __forceinline__ static void dec(int local, int& pm, int& pn) {
        constexpr int nig = 8 * nN; const int gid = local / nig, fm = gid * 8, gsz = (nM - fm) < 8 ? (nM - fm) : 8, rem = local % nig; pm = fm + rem % gsz; pn = rem / gsz; }
    __device__ __forceinline__ bool next(int i, Unit& u) const {
        const int L = i * G + c; if (L >= nwg) return false;
        int wgid; { constexpr int q = nwg / NXCD, r = nwg % NXCD; const int xcd = L % NXCD, off = L / NXCD; wgid = (xcd < r ? xcd * (q + 1) : r * (q + 1) + (xcd - r) * q) + off; }
        int pm, pn;
        if (wgid < D::n0) { dec<D::nM0, D::nN0>(wgid, pm, pn); u.kind = 0; u.a = base + D::A0 + (size_t)pm * D::tstep; u.b = base + D::B0 + (size_t)pn * D::tstep; }
        else if (wgid < D::n0 + D::n1) { dec<D::nM1, D::nN1>(wgid - D::n0, pm, pn); u.kind = 1; u.a = base + D::A1 + (size_t)pm * D::tstep; u.b = base + D::B1 + (size_t)pn * D::tstep; }
        else { dec<D::nM2, D::nN2>(wgid - D::n0 - D::n1, pm, pn); u.kind = 2; u.a = base + D::A2 + (size_t)pm * D::tstep; u.b = base + D::B2 + (size_t)pn * D::tstep; }
        u.pm = pm; u.pn = pn; return true;
    }
};
}
using pg8::Unit;
typedef f32x4 Acc[2][2][4][2];

struct EpiP1 {
    bf16* act; const float* ss; bf16* kc; bf16* vt; const float* rsm;
    static constexpr int INIT_LOADS = 0;
    __device__ __forceinline__ void init(Acc& acc, const Unit&, int, int, int, int) const {
#pragma unroll
        for (int a = 0; a < 2; ++a)
#pragma unroll
            for (int b = 0; b < 2; ++b)
#pragma unroll
                for (int m = 0; m < 4; ++m)
#pragma unroll
                    for (int n = 0; n < 2; ++n) acc[a][b][m][n] = (f32x4){0.f, 0.f, 0.f, 0.f};
    }
    __device__ __forceinline__ void operator()(const Acc& acc, const Unit& u, int wr, int wc, int fr, int fq) const {
        if (u.kind == 0) {
#pragma unroll
            for (int ai = 0; ai < 2; ++ai)
#pragma unroll
                for (int m = 0; m < 4; ++m) { const int row = u.pm * 256 + ai * 128 + wr * 64 + m * 16 + fr; const float rs = rowrs(ss, row);
                    f32x4 h0, h1;
#pragma unroll
                    for (int j = 0; j < 4; ++j) { h0[j] = silu1(acc[ai][0][m][0][j] * rs) * (acc[ai][1][m][0][j] * rs); h1[j] = silu1(acc[ai][0][m][1][j] * rs) * (acc[ai][1][m][1][j] * rs); }
                    *(u32x4*)(act + (size_t)row * FF + u.pn * 128 + wc * 32 + fq * 8) = pack8(h0, h1); }
        } else if (u.kind == 1) {
#pragma unroll
            for (int ai = 0; ai < 2; ++ai)
#pragma unroll
                for (int m = 0; m < 4; ++m) { const int row = u.pm * 256 + ai * 128 + wr * 64 + m * 16 + fr; const float rs = rsm[row];
#pragma unroll
                    for (int bj = 0; bj < 2; ++bj) *(u32x4*)(kc + (size_t)row * DM + u.pn * 256 + bj * 128 + wc * 32 + fq * 8) = pack8(acc[ai][bj][m][0] * rs, acc[ai][bj][m][1] * rs); }
        } else {
            f32x4 cs0[2], cs1[2];
#pragma unroll
            for (int bj = 0; bj < 2; ++bj) { const float* p = rsm + u.pn * 256 + bj * 128 + wc * 32 + fq * 8; cs0[bj] = *(const f32x4*)p; cs1[bj] = *(const f32x4*)(p + 4); }
#pragma unroll
            for (int ai = 0; ai < 2; ++ai)
#pragma unroll
                for (int m = 0; m < 4; ++m) { const int row = u.pm * 256 + ai * 128 + wr * 64 + m * 16 + fr;
#pragma unroll
                    for (int bj = 0; bj < 2; ++bj) *(u32x4*)(vt + (size_t)row * MT + u.pn * 256 + bj * 128 + wc * 32 + fq * 8) = pack8(acc[ai][bj][m][0] * cs0[bj], acc[ai][bj][m][1] * cs1[bj]); }
        }
    }
};
struct EpiRes {
    const float* resid; float* out; bf16* xb; float* ss; float alpha, inv_alpha;
    static constexpr int INIT_LOADS = 32;
    __device__ __forceinline__ void init(Acc& acc, const Unit& u, int wr, int wc, int fr, int fq) const {
#pragma unroll
        for (int ai = 0; ai < 2; ++ai)
#pragma unroll
            for (int m = 0; m < 4; ++m) { const int row = u.pm * 256 + ai * 128 + wr * 64 + m * 16 + fr;
#pragma unroll
                for (int bj = 0; bj < 2; ++bj) { const size_t off = (size_t)row * DM + u.pn * 256 + bj * 128 + wc * 32 + fq * 8;
                    acc[ai][bj][m][0] = *(const f32x4*)(resid + off) * inv_alpha; acc[ai][bj][m][1] = *(const f32x4*)(resid + off + 4) * inv_alpha; } }
    }
    __device__ __forceinline__ void operator()(const Acc& acc, const Unit& u, int wr, int wc, int fr, int fq) const {
#pragma unroll
        for (int ai = 0; ai < 2; ++ai)
#pragma unroll
            for (int m = 0; m < 4; ++m) { const int row = u.pm * 256 + ai * 128 + wr * 64 + m * 16 + fr; float sq = 0.f;
#pragma unroll
                for (int bj = 0; bj < 2; ++bj) { const size_t off = (size_t)row * DM + u.pn * 256 + bj * 128 + wc * 32 + fq * 8;
                    const f32x4 x0 = acc[ai][bj][m][0] * alpha, x1 = acc[ai][bj][m][1] * alpha;
                    *(f32x4*)(out + off) = x0; *(f32x4*)(out + off + 4) = x1;
                    if (xb) *(u32x4*)(xb + off) = pack8(x0, x1);
                    sq += ((x0[0] * x0[0] + x0[1] * x0[1]) + (x0[2] * x0[2] + x0[3] * x0[3])) + ((x1[0] * x1[0] + x1[1] * x1[1]) + (x1[2] * x1[2] + x1[3] * x1[3])); }
                sq += __shfl_xor(sq, 16); sq += __shfl_xor(sq, 32);
                if (fq == 0) ss[(size_t)row * 16 + u.pn * 4 + wc] = sq; }
    }
};
struct EpiP3 {
    const float* ss; bf16* U; bf16* QB; const float* cs; bf16* VTS; const float* lng; const float* lnb;
    static constexpr int INIT_LOADS = 0;
    __device__ __forceinline__ void init(Acc& acc, const Unit&, int, int, int, int) const {
#pragma unroll
        for (int a = 0; a < 2; ++a)
#pragma unroll
            for (int b = 0; b < 2; ++b)
#pragma unroll
                for (int m = 0; m < 4; ++m)
#pragma unroll
                    for (int n = 0; n < 2; ++n) acc[a][b][m][n] = (f32x4){0.f, 0.f, 0.f, 0.f};
    }
    __device__ __forceinline__ void operator()(const Acc& acc, const Unit& u, int wr, int wc, int fr, int fq) const {
        if (u.kind == 0) {
#pragma unroll
            for (int ai = 0; ai < 2; ++ai)
#pragma unroll
                for (int m = 0; m < 4; ++m) { const int row = u.pm * 256 + ai * 128 + wr * 64 + m * 16 + fr; const float rs = rowrs(ss, row);
#pragma unroll
                    for (int bj = 0; bj < 2; ++bj) *(u32x4*)(U + (size_t)row * 512 + u.pn * 256 + bj * 128 + wc * 32 + fq * 8) = pack8(gelu4(acc[ai][bj][m][0] * rs), gelu4(acc[ai][bj][m][1] * rs)); }
        } else if (u.kind == 1) {
            const int which = u.pn >> 1, head = 4 * (u.pn & 1) + wc; bf16* O = QB + (size_t)which * ((size_t)T * 512); const float sc = which == 0 ? QSCALE : 1.0f;
            const bool rot = (which < 2) && (fq < 2);
#pragma unroll
            for (int ai = 0; ai < 2; ++ai)
#pragma unroll
                for (int m = 0; m < 4; ++m) { const int row = u.pm * 256 + ai * 128 + wr * 64 + m * 16 + fr; const float rs = rowrs(ss, row) * sc;
                    f32x4 z0 = acc[ai][0][m][0] * rs, z1 = acc[ai][0][m][1] * rs;
                    if (rot) { const f32x4* cp = (const f32x4*)(cs + (size_t)row * 16 + fq * 8); const f32x4 c0 = cp[0], c1 = cp[1];
                        f32x4 r0, r1;
                        r0[0] = z0[0] * c0[0] - z0[1] * c0[1]; r0[1] = z0[1] * c0[0] + z0[0] * c0[1]; r0[2] = z0[2] * c0[2] - z0[3] * c0[3]; r0[3] = z0[3] * c0[2] + z0[2] * c0[3];
                        r1[0] = z1[0] * c1[0] - z1[1] * c1[1]; r1[1] = z1[1] * c1[0] + z1[0] * c1[1]; r1[2] = z1[2] * c1[2] - z1[3] * c1[3]; r1[3] = z1[3] * c1[2] + z1[2] * c1[3];
                        z0 = r0; z1 = r1; }
                    *(u32x4*)(O + (size_t)row * 512 + head * 64 + fq * 8) = pack8(z0, z1);
                    *(u32x4*)(O + (size_t)row * 512 + head * 64 + 32 + fq * 8) = pack8(acc[ai][1][m][0] * rs, acc[ai][1][m][1] * rs); }
        } else {
#pragma unroll
            for (int bj = 0; bj < 2; ++bj) {
                f32x4 rc[2];
#pragma unroll
                for (int n = 0; n < 2; ++n)
#pragma unroll
                    for (int j = 0; j < 4; ++j) { rc[n][j] = rowrs(ss, u.pn * 256 + bj * 128 + wc * 32 + fq * 8 + n * 4 + j); if (j & 1) asm volatile("" ::: "memory"); }
#pragma unroll
                for (int ai = 0; ai < 2; ++ai) {
#pragma unroll
                    for (int n = 0; n < 2; ++n) {
                        f32x4 v[4];
#pragma unroll
                        for (int m = 0; m < 4; ++m) v[m] = gelu4(acc[ai][bj][m][n] * rc[n]);
#pragma unroll
                        for (int j = 0; j < 4; ++j) {
                            float s = (v[0][j] + v[1][j]) + (v[2][j] + v[3][j]); s = red16(s);
                            const float mean = s * (1.0f / 64.0f); float q = 0.f;
#pragma unroll
                            for (int m = 0; m < 4; ++m) { const float d = v[m][j] - mean; v[m][j] = d; q += d * d; }
                            q = red16(q); const float rstd = __builtin_amdgcn_rsqf(q * (1.0f / 64.0f) + LN_EPS);
#pragma unroll
                            for (int m = 0; m < 4; ++m) v[m][j] *= rstd;
                        }
#pragma unroll
                        for (int m = 0; m < 4; ++m) { const int ch = u.pm * 256 + ai * 128 + wr * 64 + m * 16 + fr; const float g = lng[ch], b = lnb[ch]; const f32x4 y = v[m] * g + b;
                            u32x2 w2; w2.x = pk2(y[0], y[1]); w2.y = pk2(y[2], y[3]);
                            *(u32x2*)(VTS + (size_t)ch * T + u.pn * 256 + bj * 128 + wc * 32 + fq * 8 + n * 4) = w2; }
                        __builtin_amdgcn_sched_barrier(0);
                    }
                }
            }
        }
    }
};
struct EpiQ {
    const float* ss; bf16* QX;
    static constexpr int INIT_LOADS = 0;
    __device__ __forceinline__ void init(Acc& acc, const Unit&, int, int, int, int) const {
#pragma unroll
        for (int a = 0; a < 2; ++a)
#pragma unroll
            for (int b = 0; b < 2; ++b)
#pragma unroll
                for (int m = 0; m < 4; ++m)
#pragma unroll
                    for (int n = 0; n < 2; ++n) acc[a][b][m][n] = (f32x4){0.f, 0.f, 0.f, 0.f};
    }
    __device__ __forceinline__ void operator()(const Acc& acc, const Unit& u, int wr, int wc, int fr, int fq) const {
#pragma unroll
        for (int ai = 0; ai < 2; ++ai)
#pragma unroll
            for (int m = 0; m < 4; ++m) { const int row = u.pm * 256 + ai * 128 + wr * 64 + m * 16 + fr; const float rs = rowrs(ss, row) * XSCALE;
#pragma unroll
                for (int bj = 0; bj < 2; ++bj) *(u32x4*)(QX + (size_t)row * DM + u.pn * 256 + bj * 128 + wc * 32 + fq * 8) = pack8(acc[ai][bj][m][0] * rs, acc[ai][bj][m][1] * rs); }
    }
};

#define XB_TMO      128
#define XB_XCNT(j)  (256  + 64 * (j))
#define XB_XSUB(j)  (1280 + 64 * (j))
#define XB_XGEN(j)  (2304 + 64 * (j))
#define XB_TOP      3328
#define XB_TOPGEN   3392
#define XCD_BAR_WORDS 3456
#define XB_SPIN_CAP (1u << 18)
__device__ __forceinline__ unsigned xb_ld(unsigned* p)              { return __hip_atomic_load(p, __ATOMIC_RELAXED, __HIP_MEMORY_SCOPE_AGENT); }
__device__ __forceinline__ unsigned xb_add(unsigned* p, unsigned v) { return __hip_atomic_fetch_add(p, v, __ATOMIC_RELAXED, __HIP_MEMORY_SCOPE_AGENT); }
__device__ __forceinline__ unsigned xb_xcc_id() { return (unsigned)__builtin_amdgcn_s_getreg((3 << 11) | 20) & 0xFu; }
#define XB_SPIN(cond, bar) do { unsigned _sp = 0; while (cond) { __builtin_amdgcn_s_sleep(1); \
    if ((++_sp & 255u) == 0u) { if (xb_ld(&(bar)[XB_TMO])) break; if (_sp > XB_SPIN_CAP) { atomicAdd(&(bar)[XB_TMO], 1u); break; } } } } while (0)
struct XcdBarrier { unsigned* bar; unsigned x; volatile LAS unsigned* st; };
__device__ __forceinline__ XcdBarrier xcd_barrier_post(unsigned* bar, volatile LAS unsigned* st) {
    XcdBarrier b; b.bar = bar; b.x = xb_xcc_id(); b.st = st;
    if (threadIdx.x == 0) (void)xb_add(&bar[XB_XCNT(b.x)], 1u);
    return b;
}
__device__ __forceinline__ void xcd_barrier_complete(unsigned* bar, unsigned x, unsigned& nloc, unsigned& nx) {
    const unsigned G = gridDim.x * gridDim.y * gridDim.z;
    unsigned sum, cnt, mine, sp = 0u;
    for (;;) {
        sum = 0u; cnt = 0u; mine = 0u;
#pragma unroll
        for (unsigned j = 0; j < 16; ++j) { const unsigned c = xb_ld(&bar[XB_XCNT(j)]); sum += c; cnt += (c > 0u) ? 1u : 0u; mine = (j == x) ? c : mine; }
        if (sum == G) break;
        __builtin_amdgcn_s_sleep(1);
        if ((++sp & 255u) == 0u) { if (xb_ld(&bar[XB_TMO])) break; if (sp > XB_SPIN_CAP) { atomicAdd(&bar[XB_TMO], 1u); break; } }
    }
    nloc = mine > 0u ? mine : 1u; nx = cnt > 0u ? cnt : 1u;
}
__device__ __forceinline__ void xcd_barrier(const XcdBarrier& b) {
    asm volatile("s_waitcnt vmcnt(0)" ::: "memory");
    __syncthreads();
    if (threadIdx.x == 0) {
        unsigned* bar = b.bar;
        __builtin_amdgcn_s_waitcnt(0);
        unsigned nloc = b.st[0], nx = b.st[1];
        if (nloc == 0u) { xcd_barrier_complete(bar, b.x, nloc, nx); b.st[0] = nloc; b.st[1] = nx; }
        const unsigned old = xb_add(&bar[XB_XSUB(b.x)], 1u);
        const unsigned gen = old / nloc;
        if (old + 1u == (gen + 1u) * nloc) {
            __builtin_amdgcn_fence(__ATOMIC_RELEASE, "agent");
            asm volatile("s_waitcnt vmcnt(0)" ::: "memory");
            const unsigned og = xb_add(&bar[XB_TOP], 1u);
            const unsigned tg = og / nx;
            if (og + 1u == (tg + 1u) * nx) xb_add(&bar[XB_TOPGEN], 1u);
            else XB_SPIN(xb_ld(&bar[XB_TOPGEN]) == tg, bar);
            __builtin_amdgcn_fence(__ATOMIC_ACQUIRE, "agent");
            xb_add(&bar[XB_XGEN(b.x)], 1u);
            asm volatile("s_waitcnt vmcnt(0)" ::: "memory");
        } else {
            XB_SPIN(xb_ld(&bar[XB_XGEN(b.x)]) == gen, bar);
            __builtin_amdgcn_fence(__ATOMIC_ACQUIRE, "agent");
            asm volatile("s_waitcnt vmcnt(0)" ::: "memory");
        }
    }
    __syncthreads();
}

struct Args { const void* in[27]; float* out; unsigned char* ws; int ph_lo, ph_hi; };
enum { I_X = 0, I_MEM, I_POS, I_F1N, I_F1G, I_F1U, I_F1D, I_MIXN, I_WIN, I_LNG, I_LNB, I_WS, I_BS, I_ONA, I_ONB, I_WOUT, I_CN, I_MN, I_WQ, I_WK, I_WV, I_WO, I_F2N, I_F2G, I_F2U, I_F2D, I_FN };

struct WItem { const float* W; const float* gain; bf16* WT; int K, N, n0, k0, dst_row0, perm; };
__device__ __forceinline__ void p0_decode(const Args& a, int r, WItem& it) {
    unsigned char* ws = a.ws; int kb, gidx; it.K = 1024; it.perm = 0; it.gain = nullptr;
    if (r < 2816 || (r >= 8064 && r < 10880)) {
        const bool second = r >= 8064; if (second) r -= 8064;
        kb = r & 15; gidx = r >> 4; const int pn = gidx >> 3, bj = (gidx >> 2) & 1, wc = gidx & 3;
        it.W = (const float*)a.in[second ? (bj ? I_F2U : I_F2G) : (bj ? I_F1U : I_F1G)]; it.gain = (const float*)a.in[second ? I_F2N : I_F1N];
        it.WT = (bf16*)(ws + (second ? WS_WGU2 : WS_WGU1)); it.N = FF; it.n0 = 128 * pn + 32 * wc;
    } else if ((r >= 2816 && r < 4224) || r >= 10880) {
        const bool second = r >= 10880; r -= second ? 10880 : 2816;
        kb = r % 44; gidx = r / 44; it.W = (const float*)a.in[second ? I_F2D : I_F1D]; it.WT = (bf16*)(ws + (second ? WS_WD2 : WS_WD1)); it.K = FF; it.N = DM; it.n0 = 32 * gidx;
    } else if (r < 5504) {
        r -= 4224; kb = r & 15; gidx = r >> 4; const int pn = gidx >> 3;
        it.W = (const float*)a.in[I_WIN]; it.gain = (const float*)a.in[I_MIXN]; it.WT = (bf16*)(ws + WS_WIN); it.N = 2560;
        if (pn < 4) it.n0 = 32 * gidx;
        else { const int which = (pn - 4) >> 1, bj = (gidx >> 2) & 1, wc = gidx & 3, head = 4 * ((pn - 4) & 1) + wc; it.n0 = 1024 + 512 * which + 64 * head + 32 * bj; it.perm = (which < 2 && bj == 0) ? 1 : 0; }
    } else {
        r -= 5504; const int mid = r >> 9; r &= 511; kb = r & 15; gidx = r >> 4; it.N = DM; it.n0 = 32 * gidx;
        if (mid == 0) { it.W = (const float*)a.in[I_WOUT]; it.WT = (bf16*)(ws + WS_WOUT); it.gain = (kb < 8) ? (const float*)a.in[I_ONA] : (const float*)a.in[I_ONB] - 512; }
        else if (mid == 1) { it.W = (const float*)a.in[I_WQ]; it.WT = (bf16*)(ws + WS_WQ); it.gain = (const float*)a.in[I_CN]; }
        else if (mid == 2) { it.W = (const float*)a.in[I_WK]; it.WT = (bf16*)(ws + WS_WK); it.gain = (const float*)a.in[I_MN]; }
        else if (mid == 3) { it.W = (const float*)a.in[I_WV]; it.WT = (bf16*)(ws + WS_WV); it.gain = (const float*)a.in[I_MN]; }
        else { it.W = (const float*)a.in[I_WO]; it.WT = (bf16*)(ws + WS_WO); }
    }
    it.k0 = 64 * kb; it.dst_row0 = 32 * gidx;
}
__device__ __forceinline__ void p0_load(const WItem& it, int lane, f32x4 (&v)[8]) {
    const int aa = lane & 7, b = lane >> 3; const float* p = it.W + (size_t)(it.k0 + 8 * aa) * it.N + it.n0 + 4 * b;
#pragma unroll
    for (int i = 0; i < 8; ++i) v[i] = *(const f32x4*)(p + (size_t)i * it.N);
}
__device__ __forceinline__ void p0_store(const WItem& it, int lane, const f32x4 (&v)[8]) {
    const int aa = lane & 7, b = lane >> 3;
    f32x4 g0 = {1.f, 1.f, 1.f, 1.f}, g1 = g0; if (it.gain) { g0 = *(const f32x4*)(it.gain + it.k0 + 8 * aa); g1 = *(const f32x4*)(it.gain + it.k0 + 8 * aa + 4); }
#pragma unroll
    for (int j = 0; j < 4; ++j) { const int s = 4 * b + j; int prow = s; if (it.perm && s < 16) prow = s < 8 ? 2 * s : 2 * (s - 8) + 1;
        u32x4 o; o.x = pk2(v[0][j] * g0[0], v[1][j] * g0[1]); o.y = pk2(v[2][j] * g0[2], v[3][j] * g0[3]); o.z = pk2(v[4][j] * g1[0], v[5][j] * g1[1]); o.w = pk2(v[6][j] * g1[2], v[7][j] * g1[3]);
        *(u32x4*)(it.WT + (size_t)(it.dst_row0 + prow) * it.K + it.k0 + 8 * aa) = o; }
}
__device__ __forceinline__ float row_to_bf16(const float* xrow, bf16* orow, int lane) {
    const f32x4* xr = (const f32x4*)xrow + lane; f32x4 v[4]; float s = 0.f;
#pragma unroll
    for (int j = 0; j < 4; ++j) { v[j] = xr[64 * j]; s += (v[j][0] * v[j][0] + v[j][1] * v[j][1]) + (v[j][2] * v[j][2] + v[j][3] * v[j][3]); }
    u32x2* o8 = (u32x2*)orow + lane;
#pragma unroll
    for (int j = 0; j < 4; ++j) { u32x2 w; w.x = pk2(v[j][0], v[j][1]); w.y = pk2(v[j][2], v[j][3]); o8[64 * j] = w; }
    return wave_sum(s);
}
__device__ __forceinline__ void p0_prologue(const Args& a, int vcu, int G, int wave, int lane) {
    unsigned char* ws = a.ws;
    const int gw = vcu * 8 + wave, NGW = G * 8;
    for (int r = gw; r < 12288; r += 2 * NGW) {
        WItem i0, i1; f32x4 v0[8], v1[8]; const bool two = r + NGW < 12288;
        p0_decode(a, r, i0); p0_load(i0, lane, v0);
        if (two) { p0_decode(a, r + NGW, i1); p0_load(i1, lane, v1); }
        p0_store(i0, lane, v0);
        if (two) p0_store(i1, lane, v1);
    }
    const float* x = (const float*)a.in[I_X]; bf16* XB = (bf16*)(ws + WS_XB); float* SS = (float*)(ws + WS_SS);
    for (int m = gw; m < T; m += 2 * NGW) {
        const int m2 = m + NGW; const bool two = m2 < T;
        const f32x4* xa = (const f32x4*)(x + (size_t)m * DM) + lane; const f32x4* xb2 = (const f32x4*)(x + (size_t)(two ? m2 : m) * DM) + lane; f32x4 va[4], vb[4];
#pragma unroll
        for (int j = 0; j < 4; ++j) { va[j] = xa[64 * j]; vb[j] = xb2[64 * j]; }
        float sa = 0.f, sb = 0.f; u32x2* oa = (u32x2*)(XB + (size_t)m * DM) + lane; u32x2* ob = (u32x2*)(XB + (size_t)m2 * DM) + lane;
#pragma unroll
        for (int j = 0; j < 4; ++j) { sa += (va[j][0] * va[j][0] + va[j][1] * va[j][1]) + (va[j][2] * va[j][2] + va[j][3] * va[j][3]); sb += (vb[j][0] * vb[j][0] + vb[j][1] * vb[j][1]) + (vb[j][2] * vb[j][2] + vb[j][3] * vb[j][3]);
            u32x2 w; w.x = pk2(va[j][0], va[j][1]); w.y = pk2(va[j][2], va[j][3]); oa[64 * j] = w;
            if (two) { u32x2 w2; w2.x = pk2(vb[j][0], vb[j][1]); w2.y = pk2(vb[j][2], vb[j][3]); ob[64 * j] = w2; } }
        sa = wave_sum(sa); sb = wave_sum(sb);
        if (lane < 16) { SS[(size_t)m * 16 + lane] = lane == 0 ? sa : 0.f; if (two) SS[(size_t)m2 * 16 + lane] = lane == 0 ? sb : 0.f; }
    }
    const float* mem = (const float*)a.in[I_MEM]; bf16* MB = (bf16*)(ws + WS_MEMB); float* RSM = (float*)(ws + WS_RSM);
    for (int m = gw; m < MT; m += NGW) { const float s = row_to_bf16(mem + (size_t)m * DM, MB + (size_t)m * DM, lane); if (lane == 0) RSM[m] = __builtin_amdgcn_rsqf(s * (1.0f / 1024.0f) + NORM_EPS); }
    const int* pos = (const int*)a.in[I_POS]; f32x2* CS = (f32x2*)(ws + WS_ROPE);
    for (int idx = gw * 64 + lane; idx < T * 8; idx += NGW * 64) { const int tk = idx >> 3, i = idx & 7;
        const double invf = i == 0 ? 1.0 : i == 1 ? 0.19391225063638487 : i == 2 ? 0.037601960996863515 : i == 3 ? 0.0072914808853338354 : i == 4 ? 0.0014142135623730951 :
                            i == 5 ? 0.00027423333514461252 : i == 6 ? 5.3177203390060722e-05 : 1.0311711194248059e-05;
        const double turns = (double)pos[tk] * invf * 0.15915494309189535; const float fr = (float)(turns - __builtin_rint(turns));
        CS[idx] = (f32x2){__builtin_amdgcn_cosf(fr), __builtin_amdgcn_sinf(fr)}; }
    const float* wsrc = (const float*)a.in[I_WS]; bf16* WSB = (bf16*)(ws + WS_WSB);
    for (int idx = gw * 64 + lane; idx < 8 * 128 * 128 / 2; idx += NGW * 64) { const int e = idx * 2, j = e & 127, i = (e >> 7) & 127;
        const float v0 = j <= i ? wsrc[e] : 0.f, v1 = (j + 1) <= i ? wsrc[e + 1] : 0.f; ((unsigned*)WSB)[idx] = pk2(v0, v1); }
}

#define MFMA32(a, b, c) __builtin_amdgcn_mfma_f32_32x32x16_bf16((a), (b), (c), 0, 0, 0)
__device__ __forceinline__ bf16x8 ldg8(const bf16* p) { return *(const bf16x8*)p; }
__device__ __forceinline__ bf16x8 pack_step(const f32x16& x, int s) {
    u32x4 p; p.x = pk2(x[8 * s], x[8 * s + 1]); p.y = pk2(x[8 * s + 2], x[8 * s + 3]); p.z = pk2(x[8 * s + 4], x[8 * s + 5]); p.w = pk2(x[8 * s + 6], x[8 * s + 7]);
    return __builtin_bit_cast(bf16x8, p);
}
__device__ __forceinline__ void sgu_unit(const Args& a, int b, int ck, int g, int lane) {
    unsigned char* ws = a.ws; const int l31 = lane & 31, hh = lane >> 5, tok0 = b * SEQ + ck * 128;
    const bf16* VTS = (const bf16*)(ws + WS_VTS); const bf16* WSB = (const bf16*)(ws + WS_WSB); const bf16* U = (const bf16*)(ws + WS_U);
    bf16* YA = (bf16*)(ws + WS_YA); float* SSA = (float*)(ws + WS_SSA); const float* bs = (const float*)a.in[I_BS];
    bf16x8 af[2][8];
#pragma unroll
    for (int cb = 0; cb < 2; ++cb)
#pragma unroll
        for (int s = 0; s < 8; ++s) af[cb][s] = ldg8(VTS + (size_t)(64 * g + 32 * cb + l31) * T + tok0 + 16 * s + 8 * hh);
#pragma unroll
    for (int ib = 0; ib < 4; ++ib) {
        f32x16 c0 = {}, c1 = {};
        bf16x8 wf[8];
#pragma unroll
        for (int s = 0; s < 2 * (ib + 1); ++s) wf[s] = ldg8(WSB + (size_t)(g * 128 + 32 * ib + l31) * 128 + 16 * s + 8 * hh);
        const int tok = tok0 + 32 * ib + l31; const float bsv = bs[g * 128 + 32 * ib + l31];
        u32x2 uu[2][4];
#pragma unroll
        for (int cb = 0; cb < 2; ++cb)
#pragma unroll
            for (int g4 = 0; g4 < 4; ++g4) uu[cb][g4] = *(const u32x2*)(U + (size_t)tok * 512 + 64 * g + 32 * cb + 8 * g4 + 4 * hh);
#pragma unroll
        for (int s = 0; s < 2 * (ib + 1); ++s) { c0 = MFMA32(af[0][s], wf[s], c0); c1 = MFMA32(af[1][s], wf[s], c1); }
        float sq = 0.f;
#pragma unroll
        for (int cb = 0; cb < 2; ++cb)
#pragma unroll
            for (int g4 = 0; g4 < 4; ++g4) { const size_t off = (size_t)tok * 512 + 64 * g + 32 * cb + 8 * g4 + 4 * hh; const u32x2 u2 = uu[cb][g4];
                const f32x16& cc = cb ? c1 : c0;
                const float y0 = bflo(u2.x) * (cc[4 * g4] + bsv), y1 = bfhi(u2.x) * (cc[4 * g4 + 1] + bsv), y2 = bflo(u2.y) * (cc[4 * g4 + 2] + bsv), y3 = bfhi(u2.y) * (cc[4 * g4 + 3] + bsv);
                u32x2 w; w.x = pk2(y0, y1); w.y = pk2(y2, y3); *(u32x2*)(YA + off) = w; sq += (y0 * y0 + y1 * y1) + (y2 * y2 + y3 * y3); }
        sq += __shfl_xor(sq, 32);
        if (hh == 0) SSA[(size_t)tok * 8 + g] = sq;
    }
}
constexpr int DK_PITCH = 144, DV_OFF = 32 * DK_PITCH, DIL_LDS = DV_OFF + 32 * 128;
__device__ __forceinline__ void dil_unit(const Args& a, int set, int b, int h, int w, LAS unsigned char* kl, int lane) {
    unsigned char* ws = a.ws; const int dil = set == 0 ? 1 : (set == 1 ? 4 : 16), nqb = 64 / dil, r = w / nqb, qb = w % nqb;
    const int l31 = lane & 31, hh = lane >> 5;
    const bf16* Q = (const bf16*)(ws + WS_QB) + (size_t)b * SEQ * 512 + h * 64; const bf16* Kp = (const bf16*)(ws + WS_KB) + (size_t)b * SEQ * 512 + h * 64;
    const bf16* Vp = (const bf16*)(ws + WS_VB) + (size_t)b * SEQ * 512 + h * 64;
    LAS unsigned char* vl = kl + DV_OFF;
#define TOK(m) ((size_t)((m) * dil + r))
    bf16x8 qf[4];
#pragma unroll
    for (int s = 0; s < 4; ++s) qf[s] = ldg8(Q + TOK(32 * qb + l31) * 512 + 16 * s + 8 * hh);
    f32x16 o0 = {}, o1 = {}; float mrun = -1e30f, lrun = 0.f;
    const int li = lane & 15, q4 = li >> 2, pp = li & 3, g1 = (lane >> 4) & 1;
    const LAS unsigned char* trb = vl + (4 * hh + q4) * 128 + (16 * g1 + 4 * pp) * 2;
    const LAS unsigned char* kfb = kl + l31 * DK_PITCH + hh * 16;
    const int kt0 = (qb >= 4 ? qb - 4 : 0);
    const int lrow = lane >> 3, lch = lane & 7;
    u32x4 kr[4], vr[4], kn[4], vn[4];
#pragma unroll
    for (int i = 0; i < 4; ++i) { kr[i] = *(const u32x4*)(Kp + TOK(32 * kt0 + lrow + 8 * i) * 512 + lch * 8); vr[i] = *(const u32x4*)(Vp + TOK(32 * kt0 + lrow + 8 * i) * 512 + lch * 8); }
    for (int kt = kt0; kt <= qb; ++kt) {
        if (kt < qb) {
#pragma unroll
            for (int i = 0; i < 4; ++i) { kn[i] = *(const u32x4*)(Kp + TOK(32 * (kt + 1) + lrow + 8 * i) * 512 + lch * 8); vn[i] = *(const u32x4*)(Vp + TOK(32 * (kt + 1) + lrow + 8 * i) * 512 + lch * 8); }
        }
#pragma unroll
        for (int i = 0; i < 4; ++i) { *(LAS u32x4*)(kl + (lrow + 8 * i) * DK_PITCH + lch * 16) = kr[i]; *(LAS u32x4*)(vl + (lrow + 8 * i) * 128 + lch * 16) = vr[i]; }
        asm volatile("s_waitcnt lgkmcnt(0)" ::: "memory");
        f32x16 sc = {};
#pragma unroll
        for (int s = 0; s < 4; ++s) sc = MFMA32(*(const LAS bf16x8*)(kfb + s * 32), qf[s], sc);
        if (kt == qb) {
#pragma unroll
            for (int i = 0; i < 16; ++i) if (crow(i, hh) > l31) sc[i] = -INFINITY;
        }
        if (kt == qb - 4) {
#pragma unroll
            for (int i = 0; i < 16; ++i) if (crow(i, hh) < l31) sc[i] = -INFINITY;
        }
        float tm = sc[0];
#pragma unroll
        for (int i = 1; i < 16; ++i) tm = fmaxf(tm, sc[i]);
        tm = fmaxf(tm, __shfl_xor(tm, 32));
        const float mnew = fmaxf(mrun, tm), alpha = __builtin_amdgcn_exp2f(mrun - mnew); mrun = mnew;
        float ps = 0.f;
#pragma unroll
        for (int i = 0; i < 16; ++i) { sc[i] = __builtin_amdgcn_exp2f(sc[i] - mnew); ps += sc[i]; }
        lrun = lrun * alpha + ps;
#pragma unroll
        for (int i = 0; i < 16; ++i) { o0[i] *= alpha; o1[i] *= alpha; }
        const bf16x8 p0 = pack_step(sc, 0), p1 = pack_step(sc, 1);
#pragma unroll
        for (int db = 0; db < 2; ++db)
#pragma unroll
            for (int s = 0; s < 2; ++s) {
                const v4i16_t lo = __builtin_amdgcn_ds_read_tr16_b64_v4i16((LAS v4i16_t*)(trb + s * 2048 + db * 64));
                const v4i16_t hi = __builtin_amdgcn_ds_read_tr16_b64_v4i16((LAS v4i16_t*)(trb + s * 2048 + 1024 + db * 64));
                const bf16x8 vf = (bf16x8){lo[0], lo[1], lo[2], lo[3], hi[0], hi[1], hi[2], hi[3]};
                if (db == 0) o0 = MFMA32(vf, s ? p1 : p0, o0); else o1 = MFMA32(vf, s ? p1 : p0, o1);
            }
        asm volatile("s_waitcnt lgkmcnt(0)" ::: "memory");
#pragma unroll
        for (int i = 0; i < 4; ++i) { kr[i] = kn[i]; vr[i] = vn[i]; }
    }
    const float lt = lrun + __shfl_xor(lrun, 32), inv = __builtin_amdgcn_rcpf(lt);
    const size_t tokq = (size_t)b * SEQ + TOK(32 * qb + l31);
    bf16* OG = (bf16*)(ws + WS_OG) + (size_t)set * T * 512 + tokq * 512 + h * 64;
#pragma unroll
    for (int db = 0; db < 2; ++db)
#pragma unroll
        for (int g4 = 0; g4 < 4; ++g4) { const f32x16& oo = db ? o1 : o0; u32x2 w2; w2.x = pk2(oo[4 * g4] * inv, oo[4 * g4 + 1] * inv); w2.y = pk2(oo[4 * g4 + 2] * inv, oo[4 * g4 + 3] * inv);
            *(u32x2*)(OG + 32 * db + 8 * g4 + 4 * hh) = w2; }
    if (hh == 0) ((float*)(ws + WS_LSE))[(size_t)set * T * 8 + tokq * 8 + h] = mrun + __builtin_amdgcn_logf(lt);
#undef TOK
}

constexpr int XK_PITCH = 528, XV_PITCH = 80, XV_OFF = 32 * XK_PITCH, XKV_BYTES = XV_OFF + 128 * XV_PITCH;
template <int VAR> __device__ __forceinline__ void xattn_wg(const Args& a, int b, int head, int qs, LAS unsigned char* lds, int tid, int wave, int lane) {
    unsigned char* ws = a.ws; const int l31 = lane & 31, hh = lane >> 5;
    const bf16* QX = (const bf16*)(ws + WS_QX) + ((size_t)b * SEQ + 256 * qs + 32 * wave + l31) * DM + head * 256 + 8 * hh;
    const bf16* KC = (const bf16*)(ws + WS_KC) + (size_t)b * NMEM * DM + head * 256;
    const bf16* VT = (const bf16*)(ws + WS_VT) + (size_t)head * 256 * MT + b * NMEM;
    bf16x8 qf[16];
#pragma unroll
    for (int s = 0; s < 16; ++s) qf[s] = ldg8(QX + 16 * s);
    const int krow = (l31 & ~12) | ((l31 & 4) << 1) | ((l31 & 8) >> 1);
    const int kr0 = tid >> 5, kch = tid & 31, vrw = tid >> 2, vch = tid & 3;
    const bf16* ksrc = KC + (size_t)kr0 * DM + kch * 8;
    const unsigned kdst = kr0 * XK_PITCH + kch * 16, vdst = XV_OFF + vrw * XV_PITCH + vch * 16;
    const unsigned kfo = krow * XK_PITCH + hh * 16, vfo = XV_OFF + l31 * XV_PITCH + hh * 16;
    for (int dh = 0; dh < 2; ++dh) {
        const bf16* vsrc = VT + (size_t)(dh * 128 + vrw) * MT + vch * 8;
        f32x16 o[4];
#pragma unroll
        for (int d = 0; d < 4; ++d) o[d] = (f32x16){};
        float mrun = -1e30f, lrun = 0.f;
        { const u32x4 k0 = *(const u32x4*)ksrc, k1 = *(const u32x4*)(ksrc + (size_t)16 * DM), v0 = *(const u32x4*)vsrc;
          *(LAS u32x4*)(lds + kdst) = k0; *(LAS u32x4*)(lds + kdst + 16 * XK_PITCH) = k1; *(LAS u32x4*)(lds + vdst) = v0; }
        __syncthreads();
        for (int kt = 0; kt < 8; ++kt) {
            LAS unsigned char* cur = lds + (VAR == 2 ? 0 : (kt & 1)) * XKV_BYTES; LAS unsigned char* nxt = lds + ((kt + 1) & 1) * XKV_BYTES;
            u32x4 k0, k1, v0;
            if (VAR != 2 && kt < 7) { k0 = *(const u32x4*)(ksrc + (size_t)(32 * (kt + 1)) * DM); k1 = *(const u32x4*)(ksrc + (size_t)(32 * (kt + 1) + 16) * DM); v0 = *(const u32x4*)(vsrc + 32 * (kt + 1)); }
            f32x16 sc = {};
#pragma unroll
            for (int s = 0; s < 16; ++s) sc = MFMA32(*(const LAS bf16x8*)(cur + kfo + s * 32), qf[s], sc);
            float alpha = 1.0f;
            if (VAR != 1) {
            float tm = sc[0];
#pragma unroll
            for (int i = 1; i < 16; ++i) tm = fmaxf(tm, sc[i]);
            tm = fmaxf(tm, __shfl_xor(tm, 32));
            const float mnew = fmaxf(mrun, tm); alpha = __builtin_amdgcn_exp2f(mrun - mnew); mrun = mnew;
            float ps = 0.f;
#pragma unroll
            for (int i = 0; i < 16; ++i) { sc[i] = __builtin_amdgcn_exp2f(sc[i] - mnew); ps += sc[i]; }
            lrun = lrun * alpha + ps;
            } else lrun += sc[0];
            const bf16x8 p0 = pack_step(sc, 0), p1 = pack_step(sc, 1);
            const bool resc = !__all(alpha == 1.0f);
#pragma unroll
            for (int d = 0; d < 4; ++d) {
                if (resc) {
#pragma unroll
                    for (int e = 0; e < 16; ++e) o[d][e] *= alpha;
                }
                o[d] = MFMA32(*(const LAS bf16x8*)(cur + vfo + d * 32 * XV_PITCH), p0, o[d]);
                o[d] = MFMA32(*(const LAS bf16x8*)(cur + vfo + d * 32 * XV_PITCH + 32), p1, o[d]);
            }
            if (VAR != 2 && kt < 7) { *(LAS u32x4*)(nxt + kdst) = k0; *(LAS u32x4*)(nxt + kdst + 16 * XK_PITCH) = k1; *(LAS u32x4*)(nxt + vdst) = v0; }
            __syncthreads();
        }
        const float lt = lrun + __shfl_xor(lrun, 32), inv = __builtin_amdgcn_rcpf(lt);
        bf16* OX = (bf16*)(ws + WS_OX) + ((size_t)b * SEQ + 256 * qs + 32 * wave + l31) * DM + head * 256 + dh * 128 + 4 * hh;
#pragma unroll
        for (int d = 0; d < 4; ++d)
#pragma unroll
            for (int g4 = 0; g4 < 4; ++g4) { u32x2 w2; w2.x = pk2(o[d][4 * g4] * inv, o[d][4 * g4 + 1] * inv); w2.y = pk2(o[d][4 * g4 + 2] * inv, o[d][4 * g4 + 3] * inv);
                *(u32x2*)(OX + 32 * d + 8 * g4) = w2; }
    }
}

constexpr size_t TS1024 = (size_t)256 * 1024 * 2, TS2816 = (size_t)256 * FF * 2;
struct DP1 { static constexpr size_t tstep = TS1024, A0 = WS_XB, B0 = WS_WGU1, A1 = WS_MEMB, B1 = WS_WK, A2 = WS_WV, B2 = WS_MEMB; static constexpr int nM0 = 64, nN0 = 22, n0 = 1408, nM1 = 8, nN1 = 4, n1 = 32, nM2 = 4, nN2 = 8, n2 = 32; };
struct DP2 { static constexpr size_t tstep = TS2816, A0 = WS_ACT, B0 = WS_WD1, A1 = 0, B1 = 0, A2 = 0, B2 = 0; static constexpr int nM0 = 64, nN0 = 4, n0 = 256, nM1 = 1, nN1 = 1, n1 = 0, nM2 = 1, nN2 = 1, n2 = 0; };
struct P3Sched {
    const char* base; int G, c;
    __device__ __forceinline__ bool next(int i, Unit& u) const {
        if (G != 256) {
            const int L = i * G + c; if (L >= 640) return false;
            if (L < 128) { u.kind = 2; u.pm = L & 1; u.pn = L >> 1; } else { const int e = L - 128; u.pm = e & 63; const int col = e >> 6; u.kind = col < 2 ? 0 : 1; u.pn = col < 2 ? col : col - 2; }
        } else {
            const int x = c & 7, slot = i * 32 + (c >> 3); if (slot >= 80) return false;
            if (slot < 16) { u.kind = 2; u.pm = slot & 1; u.pn = 8 * x + (slot >> 1); }
            else { const int e = slot - 16, col = e >> 3; u.pm = 8 * x + (e & 7); u.kind = col < 2 ? 0 : 1; u.pn = col < 2 ? col : col - 2; }
        }
        if (u.kind == 0) { u.a = base + WS_XB + (size_t)u.pm * TS1024; u.b = base + WS_WIN + (size_t)u.pn * TS1024; }
        else if (u.kind == 1) { u.a = base + WS_XB + (size_t)u.pm * TS1024; u.b = base + WS_WIN + (size_t)1024 * 1024 * 2 + (size_t)u.pn * TS1024; }
        else { u.a = base + WS_WIN + (size_t)512 * 1024 * 2 + (size_t)u.pm * TS1024; u.b = base + WS_XB + (size_t)u.pn * TS1024; }
        return true;
    }
};
struct DP6 { static constexpr size_t tstep = TS1024, A0 = WS_Y, B0 = WS_WOUT, A1 = 0, B1 = 0, A2 = 0, B2 = 0; static constexpr int nM0 = 64, nN0 = 4, n0 = 256, nM1 = 1, nN1 = 1, n1 = 0, nM2 = 1, nN2 = 1, n2 = 0; };
struct DP7 { static constexpr size_t tstep = TS1024, A0 = WS_XB, B0 = WS_WQ, A1 = 0, B1 = 0, A2 = 0, B2 = 0; static constexpr int nM0 = 64, nN0 = 4, n0 = 256, nM1 = 1, nN1 = 1, n1 = 0, nM2 = 1, nN2 = 1, n2 = 0; };
struct DP9 { static constexpr size_t tstep = TS1024, A0 = WS_OX, B0 = WS_WO, A1 = 0, B1 = 0, A2 = 0, B2 = 0; static constexpr int nM0 = 64, nN0 = 4, n0 = 256, nM1 = 1, nN1 = 1, n1 = 0, nM2 = 1, nN2 = 1, n2 = 0; };
struct DP10 { static constexpr size_t tstep = TS1024, A0 = WS_XB, B0 = WS_WGU2, A1 = 0, B1 = 0, A2 = 0, B2 = 0; static constexpr int nM0 = 64, nN0 = 22, n0 = 1408, nM1 = 1, nN1 = 1, n1 = 0, nM2 = 1, nN2 = 1, n2 = 0; };
struct DP11 { static constexpr size_t tstep = TS2816, A0 = WS_ACT, B0 = WS_WD2, A1 = 0, B1 = 0, A2 = 0, B2 = 0; static constexpr int nM0 = 64, nN0 = 4, n0 = 256, nM1 = 1, nN1 = 1, n1 = 0, nM2 = 1, nN2 = 1, n2 = 0; };

__global__ void __launch_bounds__(512, 2) mk_fwd(Args args) {
    extern __shared__ __attribute__((aligned(16))) unsigned char lds_raw[];
    LAS unsigned char* lds = (LAS unsigned char*)lds_raw;
    const int tid = threadIdx.x, lane = tid & 63, wave = __builtin_amdgcn_readfirstlane(tid >> 6);
    const int G = gridDim.x, bx = blockIdx.x, vcu = (G % 8 == 0) ? (bx % 8) * (G / 8) + bx / 8 : bx;
    unsigned char* ws = args.ws;
    const int gw = vcu * 8 + wave, NGW = G * 8;
    const int lo = args.ph_lo, hi = args.ph_hi;
#if !MK_PER_PHASE
    volatile LAS unsigned* MISC = (volatile LAS unsigned*)(lds + MISC_OFF);
    for (int u = tid; u < (LDS_BYTES - LDSCTL_OFF) / 4; u += 512) ((LAS unsigned*)(lds + LDSCTL_OFF))[u] = 0u;
    __syncthreads();
    XcdBarrier bar = xcd_barrier_post((unsigned*)(ws + WS_CTL) + CW_BAR, MISC + 8);
#define GRID_BAR() xcd_barrier(bar)
    STAMP0();
#else
#define GRID_BAR() do { } while (0)
#endif
#define IN(k) (lo <= (k) && (k) < hi)
#if MK_TIMING
#define STAMP(i) do { if (tid == 0) MISC[16 + (i)] = (unsigned)__builtin_amdgcn_s_memrealtime(); } while (0)
#else
#define STAMP(i) do { } while (0)
#endif
#define SEAM(k) do { if (IN((k) + 1)) GRID_BAR(); STAMP((k) + 1); } while (0)
    float* out = args.out;
    bf16* XB = (bf16*)(ws + WS_XB); float* SS = (float*)(ws + WS_SS);

    if (IN(0)) { REP(0) p0_prologue(args, vcu, G, wave, lane); SEAM(0); }

    if (IN(1)) { REP(1) {
        pg8::MultiSched<DP1> S{(const char*)ws, G, bx};
        EpiP1 E{(bf16*)(ws + WS_ACT), SS, (bf16*)(ws + WS_KC), (bf16*)(ws + WS_VT), (const float*)(ws + WS_RSM)};
        pg8::gemm_phase(lds, 1024, S, E); } SEAM(1);
    }
    if (IN(2)) { REP(2) {
        pg8::MultiSched<DP2> S{(const char*)ws, G, bx};
        EpiRes E{(const float*)args.in[I_X], out, XB, SS, 0.5f, 2.0f};
        pg8::gemm_phase(lds, FF, S, E); } SEAM(2);
    }
    if (IN(3)) { REP(3) {
        P3Sched S{(const char*)ws, G, bx};
        EpiP3 E{SS, (bf16*)(ws + WS_U), (bf16*)(ws + WS_QB), (const float*)(ws + WS_ROPE), (bf16*)(ws + WS_VTS), (const float*)args.in[I_LNG], (const float*)args.in[I_LNB]};
        pg8::gemm_phase(lds, 1024, S, E); } SEAM(3);
    }
    if (IN(4)) { REP(4) {
        LAS unsigned char* vl = lds + wave * DIL_LDS;
        for (int uid = gw; uid < 12288; uid += NGW) { const int w = uid & 63, h = (uid >> 6) & 7, b = (uid >> 9) & 7, set = uid >> 12; dil_unit(args, set, b, h, w, vl, lane); }
        for (int v = wave * G + vcu; v < 1024; v += 8 * G) sgu_unit(args, v >> 7, (v >> 3) & 15, v & 7, lane);
        }
        SEAM(4);
    }
    if (IN(5)) { REP(5) {
        const bf16* YA = (const bf16*)(ws + WS_YA); const float* SSA = (const float*)(ws + WS_SSA); const float* LSE = (const float*)(ws + WS_LSE); const bf16* OG = (const bf16*)(ws + WS_OG);
        bf16* Y = (bf16*)(ws + WS_Y);
        for (int row = gw; row < T; row += NGW) {
            const int c0 = 8 * lane, head = lane >> 3;
            const f32x4 s0 = *(const f32x4*)(SSA + (size_t)row * 8), s1 = *(const f32x4*)(SSA + (size_t)row * 8 + 4);
            const float rsa = __builtin_amdgcn_rsqf((((s0[0] + s0[1]) + (s0[2] + s0[3])) + ((s1[0] + s1[1]) + (s1[2] + s1[3]))) * (1.0f / 512.0f) + NORM_EPS);
            const u32x4 ya = *(const u32x4*)(YA + (size_t)row * 512 + c0);
            const float l0 = LSE[(size_t)row * 8 + head], l1 = LSE[(size_t)T * 8 + (size_t)row * 8 + head], l2 = LSE[(size_t)2 * T * 8 + (size_t)row * 8 + head];
            const float mx = fmaxf(l0, fmaxf(l1, l2)); float w0 = __builtin_amdgcn_exp2f(l0 - mx), w1 = __builtin_amdgcn_exp2f(l1 - mx), w2 = __builtin_amdgcn_exp2f(l2 - mx);
            const float wi = __builtin_amdgcn_rcpf(w0 + w1 + w2); w0 *= wi; w1 *= wi; w2 *= wi;
            const u32x4 g0 = *(const u32x4*)(OG + (size_t)row * 512 + c0), g1 = *(const u32x4*)(OG + (size_t)T * 512 + (size_t)row * 512 + c0), g2 = *(const u32x4*)(OG + (size_t)2 * T * 512 + (size_t)row * 512 + c0);
            float yb[8]; float sq = 0.f;
#pragma unroll
            for (int k = 0; k < 4; ++k) { yb[2 * k] = w0 * bflo(g0[k]) + w1 * bflo(g1[k]) + w2 * bflo(g2[k]); yb[2 * k + 1] = w0 * bfhi(g0[k]) + w1 * bfhi(g1[k]) + w2 * bfhi(g2[k]); sq += yb[2 * k] * yb[2 * k] + yb[2 * k + 1] * yb[2 * k + 1]; }
            const float rsb = __builtin_amdgcn_rsqf(wave_sum(sq) * (1.0f / 512.0f) + NORM_EPS);
            u32x4 oa, ob;
#pragma unroll
            for (int k = 0; k < 4; ++k) { oa[k] = pk2(bflo(ya[k]) * rsa, bfhi(ya[k]) * rsa); ob[k] = pk2(yb[2 * k] * rsb, yb[2 * k + 1] * rsb); }
            *(u32x4*)(Y + (size_t)row * DM + c0) = oa; *(u32x4*)(Y + (size_t)row * DM + 512 + c0) = ob;
        }
        }
        SEAM(5);
    }
    if (IN(6)) {
        pg8::MultiSched<DP6> S{(const char*)ws, G, bx};
        EpiRes E{out, out, XB, SS, 1.0f, 1.0f};
        pg8::gemm_phase(lds, 1024, S, E); SEAM(6);
    }
    if (IN(7)) { REP(7) {
        pg8::MultiSched<DP7> S{(const char*)ws, G, bx};
        EpiQ E{SS, (bf16*)(ws + WS_QX)};
        pg8::gemm_phase(lds, 1024, S, E); } SEAM(7);
    }
    if (IN(8)) {
#if PROBE_DUP >= 80 && PROBE_DUP < 90
        for (int u = vcu; u < 256; u += G) xattn_wg<PROBE_DUP - 80>(args, u >> 5, (u >> 3) & 3, u & 7, lds, tid, wave, lane);
#endif
        REP(8) {
        for (int u = vcu; u < 256; u += G) xattn_wg<0>(args, u >> 5, (u >> 3) & 3, u & 7, lds, tid, wave, lane);
        }
        SEAM(8);
    }
    if (IN(9)) {
        pg8::MultiSched<DP9> S{(const char*)ws, G, bx};
        EpiRes E{out, out, XB, SS, 1.0f, 1.0f};
        pg8::gemm_phase(lds, 1024, S, E); SEAM(9);
    }
    if (IN(10)) { REP(10) {
        pg8::MultiSched<DP10> S{(const char*)ws, G, bx};
        EpiP1 E{(bf16*)(ws + WS_ACT), SS, nullptr, nullptr, nullptr};
        pg8::gemm_phase(lds, 1024, S, E); } SEAM(10);
    }
    if (IN(11)) {
        pg8::MultiSched<DP11> S{(const char*)ws, G, bx};
        EpiRes E{out, out, nullptr, SS, 0.5f, 2.0f};
        pg8::gemm_phase(lds, FF, S, E); SEAM(11);
    }
    if (IN(12)) {
        const float* gf = (const float*)args.in[I_FN];
#if MK_TIMING
        unsigned* tw = (unsigned*)(ws + WS_CTL) + 2048;
        if (bx == 0 && tid == 0) { __hip_atomic_store(tw, MISC[16 + PROBE_A + 1] - MISC[16 + PROBE_A], __ATOMIC_RELAXED, __HIP_MEMORY_SCOPE_AGENT); __hip_atomic_store(tw + 1, MISC[16 + PROBE_B + 1] - MISC[16 + PROBE_B], __ATOMIC_RELAXED, __HIP_MEMORY_SCOPE_AGENT); }
        GRID_BAR();
        const float encA = 1000.0f * 0.01f * (float)__hip_atomic_load(tw, __ATOMIC_RELAXED, __HIP_MEMORY_SCOPE_AGENT), encB = 100.0f * 0.01f * (float)__hip_atomic_load(tw + 1, __ATOMIC_RELAXED, __HIP_MEMORY_SCOPE_AGENT);
#endif
        for (int row = gw; row < T; row += NGW) { const float rs = rowrs(SS, row); f32x4* xr = (f32x4*)(out + (size_t)row * DM) + lane; const f32x4* gr = (const f32x4*)gf + lane;
#pragma unroll
            for (int j = 0; j < 4; ++j) { f32x4 y = xr[64 * j] * rs * gr[64 * j];
#if MK_TIMING
                if (row >= 1 && row < 1025) y = y + encB; if (row == 0 && lane == 0 && j == 0) y[0] += encA;
#endif
                xr[64 * j] = y; } }
    }
#undef IN
#undef SEAM
}

#if MK_DEBUG
#include "dbg_checks.inc"
#endif

extern "C" void kernel_launch(void* const* d_in, const int* in_sizes, int n_in, void* d_out, int out_size, void* d_ws, size_t ws_size, hipStream_t stream) {
    static int grid = 0;
    if (grid == 0) {
        if (n_in != 27 || out_size != T * DM || ws_size < WS_END) { fprintf(stderr, "kernel_launch: unexpected shapes (n_in %d out %d ws %zu)\n", n_in, out_size, ws_size); grid = -1; return; }
        int dev = 0, cus = 0, per_cu = 0;
        if (hipGetDevice(&dev) != hipSuccess || hipDeviceGetAttribute(&cus, hipDeviceAttributeMultiprocessorCount, dev) != hipSuccess) { grid = -1; return; }
        if (hipFuncSetAttribute((const void*)mk_fwd, hipFuncAttributeMaxDynamicSharedMemorySize, LDS_BYTES) != hipSuccess) { fprintf(stderr, "kernel_launch: hipFuncSetAttribute failed\n"); grid = -1; return; }
        if (hipOccupancyMaxActiveBlocksPerMultiprocessor(&per_cu, (const void*)mk_fwd, 512, LDS_BYTES) != hipSuccess || per_cu < 1) { fprintf(stderr, "kernel_launch: occupancy query says %d\n", per_cu); per_cu = 1; }
        (void)hipGetLastError();
        grid = cus * (per_cu < 1 ? per_cu : 1);
    }
    if (grid < 0) return;
    (void)hipMemsetAsync((char*)d_ws + WS_CTL, 0, CTL_ZERO_BYTES, stream);
    Args a{};
    for (int i = 0; i < 27; ++i) a.in[i] = d_in[i];
    a.out = (float*)d_out; a.ws = (unsigned char*)d_ws;
#if MK_PER_PHASE
    for (int ph = 0; ph < NPH; ++ph) {
        a.ph_lo = ph; a.ph_hi = ph + 1;
#if MK_DEBUG
        dbg_before(a, ph, stream);
#endif
        hipLaunchKernelGGL(mk_fwd, dim3(grid), dim3(512), LDS_BYTES, stream, a);
#if MK_DEBUG
        dbg_after(a, ph, stream);
#endif
    }
#if MK_DEBUG
    dbg_encode(a, stream);
#endif
#else
    a.ph_lo = 0; a.ph_hi = NPH;
    void* kargs[] = {&a};
#if MK_COOP
    hipError_t e = hipLaunchCooperativeKernel((const void*)mk_fwd, dim3(grid), dim3(512), kargs, LDS_BYTES, stream);
    if (e != hipSuccess) fprintf(stderr, "kernel_launch: cooperative launch failed: %s (grid %d)\n", hipGetErrorString(e), grid);
#else
    (void)kargs; hipLaunchKernelGGL(mk_fwd, dim3(grid), dim3(512), LDS_BYTES, stream, a);
#endif
#endif
}
```
